# Optimizing an MI355X kernel written in HIP

```python
import math
import jax, jax.numpy as jnp
from jax import lax
import numpy as np

D_MODEL = 4096
BATCH = 2
SEQ = 4096
DEPTH = 2

N_MIXERS = 2
N_ATTN = (DEPTH + 1) // 2
N_SSM = DEPTH // 2

N_HEADS = 64
N_KV = 8
GROUP = N_HEADS // N_KV
HEAD_DIM = 64
Q_W = N_HEADS * HEAD_DIM
KV_W = N_KV * HEAD_DIM
WINDOW = 128
BLOCK = 128

NUM_BUCKETS = 32
MAX_EXACT = NUM_BUCKETS // 2
MAX_DISTANCE = 128

SSM_GC = 16
SSM_G = D_MODEL // SSM_GC
SSM_P = 64
DT_MIN = 1e-3
DT_MAX = 1e-1

D_FF = 11008
CONV_W = 3

EPS = 1e-6
NEG = -1e30

kernel_name = "hybrid_swa_sink_s5_convffn"


def rmsnorm(x, g):
    x32 = x.astype(jnp.float32)
    y = x32 * lax.rsqrt(jnp.mean(x32 * x32, axis=-1, keepdims=True) + EPS)
    return (y * g.astype(jnp.float32)).astype(x.dtype)


def t5_buckets(dist):
    n = np.maximum(dist, 0)
    is_small = n < MAX_EXACT
    large = MAX_EXACT + (np.log(np.maximum(n, 1) / MAX_EXACT) / np.log(MAX_DISTANCE / MAX_EXACT)
                         * (NUM_BUCKETS - MAX_EXACT)).astype(np.int32)
    large = np.minimum(large, NUM_BUCKETS - 1)
    return np.where(is_small, n, large).astype(np.int32)


def swa_sink_attention(h, w_qkv, w_o, sinks, rel_bias):
    b, L, _ = h.shape
    nb = L // BLOCK
    dt = h.dtype
    qkv = h @ w_qkv
    q = qkv[..., :Q_W].reshape(b, nb, BLOCK, N_KV, GROUP, HEAD_DIM)
    k = qkv[..., Q_W:Q_W + KV_W].reshape(b, nb, BLOCK, N_KV, HEAD_DIM)
    v = qkv[..., Q_W + KV_W:].reshape(b, nb, BLOCK, N_KV, HEAD_DIM)
    pad = ((0, 0), (1, 0), (0, 0), (0, 0), (0, 0))
    kb = jnp.concatenate([jnp.pad(k, pad)[:, :-1], k], axis=2)
    vb = jnp.concatenate([jnp.pad(v, pad)[:, :-1], v], axis=2)
    s = jnp.einsum('bnqkgd,bnskd->bnkgqs', q, kb).astype(jnp.float32) * (HEAD_DIM ** -0.5)
    qi = np.arange(BLOCK)[:, None] + BLOCK
    kj = np.arange(2 * BLOCK)[None, :]
    dist = qi - kj
    local = (dist >= 0) & (dist < WINDOW)
    bias = rel_bias.astype(jnp.float32)[t5_buckets(dist)]
    bias = jnp.transpose(bias, (2, 0, 1)).reshape(N_KV, GROUP, BLOCK, 2 * BLOCK)
    blk = jnp.arange(nb)[:, None, None]
    valid = jnp.asarray(local)[None] & ((blk > 0) | jnp.asarray(kj >= BLOCK)[None])
    s = jnp.where(valid[None, :, None, None], s + bias, NEG)
    sink = sinks.astype(jnp.float32).reshape(1, 1, N_KV, GROUP, 1, 1)
    m = jnp.maximum(jnp.max(s, axis=-1, keepdims=True), sink)
    p = jnp.exp(s - m)
    p = p / (jnp.sum(p, axis=-1, keepdims=True) + jnp.exp(sink - m))
    o = jnp.einsum('bnkgqs,bnskd->bnqkgd', p.astype(dt), vb)
    return o.reshape(b, L, Q_W) @ w_o


def s5_scan_combine(e1, e2):
    ar1, ai1, br1, bi1 = e1
    ar2, ai2, br2, bi2 = e2
    ar = ar2 * ar1 - ai2 * ai1
    ai = ar2 * ai1 + ai2 * ar1
    br = ar2 * br1 - ai2 * bi1 + br2
    bi = ar2 * bi1 + ai2 * br1 + bi2
    return (ar, ai, br, bi)


def s5_layer(h, lam_re, lam_im, log_step, b_re, b_im, c_re, c_im, d_skip, w_glu):
    b, L, D = h.shape
    dt = h.dtype
    delta = jnp.exp(log_step.astype(jnp.float32))[:, None]
    lr = lam_re.astype(jnp.float32)
    li = lam_im.astype(jnp.float32)
    mag = jnp.exp(lr * delta)
    abar_r = mag * jnp.cos(li * delta)
    abar_i = mag * jnp.sin(li * delta)
    nr = abar_r - 1.0
    ni = abar_i
    den = lr * lr + li * li
    fr = ((nr * lr + ni * li) / den)[..., None]
    fi = ((ni * lr - nr * li) / den)[..., None]
    br32 = b_re.astype(jnp.float32)
    bi32 = b_im.astype(jnp.float32)
    bbar_r = (fr * br32 - fi * bi32).astype(dt)
    bbar_i = (fr * bi32 + fi * br32).astype(dt)
    u = h.reshape(b, L, SSM_G, SSM_GC)
    bu_r = jnp.einsum('blgc,gpc->blgp', u, bbar_r)
    bu_i = jnp.einsum('blgc,gpc->blgp', u, bbar_i)
    a_r = jnp.broadcast_to(abar_r.astype(dt)[None, None], (1, L, SSM_G, SSM_P))
    a_i = jnp.broadcast_to(abar_i.astype(dt)[None, None], (1, L, SSM_G, SSM_P))
    _, _, xr, xi = lax.associative_scan(s5_scan_combine, (a_r, a_i, bu_r, bu_i), axis=1)
    y = jnp.einsum('blgp,gcp->blgc', xr, c_re) - jnp.einsum('blgp,gcp->blgc', xi, c_im)
    y = y.reshape(b, L, D) + d_skip * h
    z = jax.nn.gelu(y) @ w_glu
    return z[..., :D] * jax.nn.sigmoid(z[..., D:])


def conv_gated_mlp(h, w_up, conv_w, conv_b, w_down):
    L = h.shape[1]
    u = h @ w_up
    up = jnp.pad(u, ((0, 0), (CONV_W - 1, 0), (0, 0)))
    c = conv_b + sum(conv_w[j] * up[:, j:j + L] for j in range(CONV_W))
    g = c[..., :D_FF]
    v = c[..., D_FF:]
    return (jax.nn.silu(g) * v) @ w_down


def setup_inputs(seed: int = 0) -> dict:
    key = jax.random.key(seed)
    ks = jax.random.split(key, 24)
    f32 = jnp.float32
    nrm = lambda k, shape, scale: jax.random.normal(k, shape, f32) * scale
    x = jax.random.normal(ks[0], (BATCH, SEQ, D_MODEL), f32)
    attn_norm = 1.0 + nrm(ks[1], (N_ATTN, D_MODEL), 0.02)
    w_qkv = nrm(ks[2], (N_ATTN, D_MODEL, Q_W + 2 * KV_W), D_MODEL ** -0.5)
    w_o = nrm(ks[3], (N_ATTN, Q_W, D_MODEL), Q_W ** -0.5)
    sinks = nrm(ks[4], (N_ATTN, N_HEADS), 0.5)
    rel_bias = nrm(ks[5], (NUM_BUCKETS, N_HEADS), 0.5)
    ssm_norm = 1.0 + nrm(ks[6], (N_SSM, D_MODEL), 0.02)
    n_idx = jnp.arange(SSM_P, dtype=f32)
    lambda_re = -0.5 + nrm(ks[7], (N_SSM, SSM_G, SSM_P), 0.01)
    lambda_im = math.pi * n_idx + nrm(ks[8], (N_SSM, SSM_G, SSM_P), 0.01)
    log_step = jax.random.uniform(ks[9], (N_SSM, SSM_G), f32, math.log(DT_MIN), math.log(DT_MAX))
    b_re = nrm(ks[10], (N_SSM, SSM_G, SSM_P, SSM_GC), (2 * SSM_GC) ** -0.5)
    b_im = nrm(ks[11], (N_SSM, SSM_G, SSM_P, SSM_GC), (2 * SSM_GC) ** -0.5)
    c_re = nrm(ks[12], (N_SSM, SSM_G, SSM_GC, SSM_P), (2 * SSM_P) ** -0.5)
    c_im = nrm(ks[13], (N_SSM, SSM_G, SSM_GC, SSM_P), (2 * SSM_P) ** -0.5)
    d_skip = nrm(ks[14], (N_SSM, D_MODEL), 1.0)
    w_glu = nrm(ks[15], (N_SSM, D_MODEL, 2 * D_MODEL), D_MODEL ** -0.5)
    ffn_norm = 1.0 + nrm(ks[16], (DEPTH, D_MODEL), 0.02)
    w_up = nrm(ks[17], (DEPTH, D_MODEL, 2 * D_FF), D_MODEL ** -0.5)
    conv_w = nrm(ks[18], (DEPTH, CONV_W, 2 * D_FF), CONV_W ** -0.5)
    conv_b = nrm(ks[19], (DEPTH, 2 * D_FF), 0.02)
    w_down = nrm(ks[20], (DEPTH, D_FF, D_MODEL), D_FF ** -0.5)
    final_norm = 1.0 + nrm(ks[21], (D_MODEL,), 0.02)
    return {'x': x, 'attn_norm': attn_norm, 'w_qkv': w_qkv, 'w_o': w_o, 'sinks': sinks,
            'rel_bias': rel_bias, 'ssm_norm': ssm_norm, 'lambda_re': lambda_re,
            'lambda_im': lambda_im, 'log_step': log_step, 'b_re': b_re, 'b_im': b_im,
            'c_re': c_re, 'c_im': c_im, 'd_skip': d_skip, 'w_glu': w_glu,
            'ffn_norm': ffn_norm, 'w_up': w_up, 'conv_w': conv_w, 'conv_b': conv_b,
            'w_down': w_down, 'final_norm': final_norm}


def reference(x, attn_norm, w_qkv, w_o, sinks, rel_bias, ssm_norm, lambda_re, lambda_im,
              log_step, b_re, b_im, c_re, c_im, d_skip, w_glu, ffn_norm, w_up, conv_w,
              conv_b, w_down, final_norm):
    for i in range(DEPTH):
        j = i // N_MIXERS
        if i % N_MIXERS == 0:
            x = x + swa_sink_attention(rmsnorm(x, attn_norm[j]), w_qkv[j], w_o[j], sinks[j], rel_bias)
        else:
            x = x + s5_layer(rmsnorm(x, ssm_norm[j]), lambda_re[j], lambda_im[j], log_step[j],
                             b_re[j], b_im[j], c_re[j], c_im[j], d_skip[j], w_glu[j])
        x = x + conv_gated_mlp(rmsnorm(x, ffn_norm[i]), w_up[i], conv_w[i], conv_b[i], w_down[i])
    return rmsnorm(x, final_norm)
```

```cpp
#include <hip/hip_runtime.h>
#include <cstdio>
#include <cstdint>
namespace pg8 {
#define PG8_LAS __attribute__((address_space(3)))
typedef unsigned short bf16_t;
typedef short bf16x8 __attribute__((ext_vector_type(8)));
typedef float f32x4 __attribute__((ext_vector_type(4)));
typedef unsigned u32x4 __attribute__((ext_vector_type(4)));
constexpr int BM = 256, BK = 64, HALF = 128, HTB = HALF * BK * 2  , STAGE_BYTES = 8 * HTB, NXCD = 8, WGM = 8;

__host__ __device__ __forceinline__ int lds_byte(int r, int c) { const int st = (r >> 4) * 2 + (c >> 5), rr = r & 15, cc = c & 31, ob = rr * 64 + cc * 2; return st * 1024 + (ob ^ (((ob >> 9) & 1) << 5)); }
__host__ __device__ __forceinline__ void stage_rc(int b, int& R, int& C) { const int st = b / 1024, sb = b % 1024, swz = sb ^ (((sb >> 9) & 1) << 5); R = (st >> 1) * 16 + swz / 64; C = (st & 1) * 32 + (swz % 64) / 2; }
__host__ __device__ __forceinline__ int perm32(int rho) { const int n = rho >> 4, i = rho & 15; return 8 * (i >> 2) + 4 * n + (i & 3); }

struct Unit { int pm, pn; };
struct Gemm { const bf16_t* A; const bf16_t* Bt; int M, N, K; };

struct StaticOrder {
    int nM, nN, nwg, G, c;
    __host__ __device__ void init(int M, int N, int G_, int c_) { nM = M / BM; nN = N / BM; nwg = nM * nN; G = G_; c = c_; }
    __host__ __device__ bool next(int i, Unit& u) const {
        const long L = (long)i * G + c; if (L >= nwg) return false;
        int wgid = (int)L; { const int q = nwg / NXCD, r = nwg % NXCD, xcd = wgid % NXCD, off = wgid / NXCD; wgid = (xcd < r ? xcd * (q + 1) : r * (q + 1) + (xcd - r) * q) + off; }
        const int nig = WGM * nN, gid = wgid / nig, fm = gid * WGM, gsz = (nM - fm) < WGM ? (nM - fm) : WGM;
        u.pm = fm + ((wgid % nig) % gsz); u.pn = (wgid % nig) / gsz; return true;
    }
    __device__ __forceinline__ void a_ready(const Unit&) const {}
    __device__ __forceinline__ void done(const Unit&) const {}
};

__device__ __forceinline__ unsigned cvt_pk_bf16(float lo, float hi) { unsigned r; asm volatile("v_cvt_pk_bf16_f32 %0, %1, %2" : "=v"(r) : "v"(lo), "v"(hi)); return r; }
typedef unsigned u32x2 __attribute__((ext_vector_type(2)));
__device__ __forceinline__ float fast_sigmoid(float x) { return __builtin_amdgcn_rcpf(1.0f + __builtin_amdgcn_exp2f(-1.4426950408889634f * x)); }

struct EpiBf16 {
    static constexpr bool PERM = true, AFTER_DRAIN = false;
    bf16_t* O; int ldc;
    __device__ __forceinline__ void operator()(const f32x4 (&acc)[2][2][4][2], const Unit& u, int wr, int wc, int fr, int fq) const {
        const int row0 = u.pm * BM + wr * 64 + fr; const int col0 = u.pn * BM + wc * 32 + 8 * fq;
#pragma unroll
        for (int ai = 0; ai < 2; ++ai)
#pragma unroll
            for (int m = 0; m < 4; ++m) { bf16_t* rowp = O + (size_t)(row0 + ai * HALF + m * 16) * ldc + col0;
#pragma unroll
                for (int bj = 0; bj < 2; ++bj) { const f32x4 v0 = acc[ai][bj][m][0], v1 = acc[ai][bj][m][1];
                    u32x4 w; w.x = cvt_pk_bf16(v0[0], v0[1]); w.y = cvt_pk_bf16(v0[2], v0[3]); w.z = cvt_pk_bf16(v1[0], v1[1]); w.w = cvt_pk_bf16(v1[2], v1[3]);
                    *(u32x4*)(rowp + bj * HALF) = w; } }
    }
};
struct EpiResF32 {
    static constexpr bool PERM = false, AFTER_DRAIN = false;
    const float* base; float* out; int ldc;
    __device__ __forceinline__ void operator()(const f32x4 (&acc)[2][2][4][2], const Unit& u, int wr, int wc, int fr, int fq) const {
        const int row0 = u.pm * BM + wr * 64 + fr, col0 = u.pn * BM + wc * 32 + 4 * fq;
#pragma unroll
        for (int ai = 0; ai < 2; ++ai)
#pragma unroll
            for (int m = 0; m < 4; ++m) { const size_t off = (size_t)(row0 + ai * HALF + m * 16) * ldc + col0;
#pragma unroll
                for (int bj = 0; bj < 2; ++bj)
#pragma unroll
                    for (int n = 0; n < 2; ++n) { const f32x4 b = *(const f32x4*)(base + off + bj * HALF + n * 16); *(f32x4*)(out + off + bj * HALF + n * 16) = b + acc[ai][bj][m][n]; } }
    }
};
struct EpiGluRes {
    static constexpr bool PERM = false, AFTER_DRAIN = false;
    float* X; int ldc;
    __device__ __forceinline__ void operator()(const f32x4 (&acc)[2][2][4][2], const Unit& u, int wr, int wc, int fr, int fq) const {
        const int row0 = u.pm * BM + wr * 64 + fr, col0 = u.pn * HALF + wc * 32 + 4 * fq;
#pragma unroll
        for (int ai = 0; ai < 2; ++ai)
#pragma unroll
            for (int m = 0; m < 4; ++m) { float* rowp = X + (size_t)(row0 + ai * HALF + m * 16) * ldc + col0;
#pragma unroll
                for (int n = 0; n < 2; ++n) { const f32x4 a = acc[ai][0][m][n], g = acc[ai][1][m][n]; f32x4 b = *(const f32x4*)(rowp + n * 16);
                    b[0] += a[0] * fast_sigmoid(g[0]); b[1] += a[1] * fast_sigmoid(g[1]); b[2] += a[2] * fast_sigmoid(g[2]); b[3] += a[3] * fast_sigmoid(g[3]);
                    *(f32x4*)(rowp + n * 16) = b; } }
    }
};
struct EpiConvGate {
    static constexpr bool PERM = true, AFTER_DRAIN = false;
    bf16_t* ACT; int ldc;
    float* HEAD; float* TAIL;
    const float* cw; const float* cb; int FF, NUP;
    __device__ __forceinline__ void operator()(const f32x4 (&acc)[2][2][4][2], const Unit& u, int wr, int wc, int fr, int fq) const {
        const int lane = (int)(threadIdx.x & 63u);
        const int s1 = (lane & 48) | ((fr + 15) & 15), s2 = (lane & 48) | ((fr + 14) & 15);
#pragma unroll
        for (int n = 0; n < 2; ++n) {
            const int f0 = u.pn * HALF + wc * 32 + 8 * fq + 4 * n;
            const int nn = u.pn * BM + wc * 32 + 8 * fq + 4 * n;
            f32x4 w0[2], w1[2], w2[2], bb[2];
#pragma unroll
            for (int bj = 0; bj < 2; ++bj) { const float* p = cw + bj * FF + f0; w0[bj] = *(const f32x4*)p; w1[bj] = *(const f32x4*)(p + NUP); w2[bj] = *(const f32x4*)(p + 2 * NUP); bb[bj] = *(const f32x4*)(cb + bj * FF + f0); }
#pragma unroll
            for (int ai = 0; ai < 2; ++ai) {
                const int blk = u.pm * 4 + ai * 2 + wr;
                if (fr < 2) { float* hp = HEAD + ((size_t)blk * 2 + fr) * NUP + nn; *(f32x4*)hp = acc[ai][0][0][n]; *(f32x4*)(hp + HALF) = acc[ai][1][0][n]; }
                if (fr >= 14) { float* tp = TAIL + ((size_t)blk * 2 + (fr - 14)) * NUP + nn; *(f32x4*)tp = acc[ai][0][3][n]; *(f32x4*)(tp + HALF) = acc[ai][1][3][n]; }
#pragma unroll
                for (int m = 0; m < 4; ++m) {
                    f32x4 c[2];
#pragma unroll
                    for (int bj = 0; bj < 2; ++bj) {
                        const f32x4 cur = acc[ai][bj][m][n], prv = acc[ai][bj][m > 0 ? m - 1 : 0][n];
                        f32x4 u1, u2;
#pragma unroll
                        for (int j = 0; j < 4; ++j) {
                            const float a1 = __shfl(cur[j], s1), b1 = __shfl(prv[j], s1), a2 = __shfl(cur[j], s2), b2 = __shfl(prv[j], s2);
                            u1[j] = fr >= 1 ? a1 : b1; u2[j] = fr >= 2 ? a2 : b2;
                        }
                        c[bj] = bb[bj] + w0[bj] * u2 + w1[bj] * u1 + w2[bj] * cur;
                    }
                    f32x4 o;
#pragma unroll
                    for (int j = 0; j < 4; ++j) o[j] = c[0][j] * fast_sigmoid(c[0][j]) * c[1][j];
                    u32x2 w; w.x = cvt_pk_bf16(o[0], o[1]); w.y = cvt_pk_bf16(o[2], o[3]);
                    *(u32x2*)(ACT + (size_t)(u.pm * BM + ai * HALF + wr * 64 + m * 16 + fr) * ldc + f0) = w;
                }
            }
        }
    }
};

template <class Epi, class Sched, bool ALIGN_EPI = false, bool SP2 = false>
__device__ __forceinline__ void gemm_phase(PG8_LAS unsigned char* lds, const Gemm g, const Sched& S, const Epi& E) {
    const int tid = threadIdx.x, wid = __builtin_amdgcn_readfirstlane(tid >> 6), lane = tid & 63, wr = wid >> 2, wc = wid & 3, fr = lane & 15, fq = lane >> 4;
    const int K = g.K, nt = K / BK;
    unsigned voffA[2], voffB[2];
#pragma unroll
    for (int i = 0; i < 2; ++i) { int R, C; stage_rc(tid * 16 + i * 8192, R, C); const int Rb = Epi::PERM ? ((R & ~31) + perm32(R & 31)) : R;
        voffA[i] = (unsigned)(R * K + C) * 2u; voffB[i] = (unsigned)(Rb * K + C) * 2u; }
    const size_t kstep = (size_t)(BK * 2);
    const size_t hstep = (size_t)HALF * K * 2;
    const size_t tstep = 2 * hstep;
    const unsigned ldsw = (unsigned)wid * 1024u;
    const int aoff = lds_byte(wr * 64 + fr, fq * 8), boff = lds_byte(wc * 32 + fr, fq * 8);
#define PG8_SA(b, h) (((b) * 2 + (h)) * HTB)
#define PG8_SB(b, h) ((4 + (b) * 2 + (h)) * HTB)
#define PG8_STAGE(bufoff, gbase, voff) do { _Pragma("unroll") for (int _i = 0; _i < 2; ++_i) \
        __builtin_amdgcn_global_load_lds((const unsigned*)((const char*)(gbase) + (voff)[_i]), (PG8_LAS unsigned*)(lds + (bufoff) + ldsw + _i * 8192), 16, 0, 0); } while (0)
#define PG8_LDA(dst, b, h) do { _Pragma("unroll") for (int m = 0; m < 4; ++m) _Pragma("unroll") for (int k = 0; k < 2; ++k) dst[m][k] = *(const PG8_LAS bf16x8*)(lds + PG8_SA(b, h) + aoff + m * 2048 + k * 1024); } while (0)
#define PG8_LDB(dst, b, h) do { _Pragma("unroll") for (int n = 0; n < 2; ++n) _Pragma("unroll") for (int k = 0; k < 2; ++k) dst[n][k] = *(const PG8_LAS bf16x8*)(lds + PG8_SB(b, h) + boff + n * 2048 + k * 1024); } while (0)
#define PG8_MMA(ai, bj, At, Bt) do { __builtin_amdgcn_s_setprio(1); _Pragma("unroll") for (int m = 0; m < 4; ++m) _Pragma("unroll") for (int n = 0; n < 2; ++n) _Pragma("unroll") for (int k = 0; k < 2; ++k) \
        acc[ai][bj][m][n] = __builtin_amdgcn_mfma_f32_16x16x32_bf16(Bt[n][k], At[m][k], acc[ai][bj][m][n], 0, 0, 0); __builtin_amdgcn_s_setprio(0); } while (0)
#define PG8_WAIT_V(n) asm volatile("s_waitcnt vmcnt(" #n ")" ::: "memory")
#define PG8_WAIT_L(n) asm volatile("s_waitcnt lgkmcnt(" #n ")" ::: "memory")
#define PG8_BAR __builtin_amdgcn_s_barrier()
#define PG8_SCHED __builtin_amdgcn_sched_barrier(0)
    Unit cur, nxt; int ui = 0;
    if (!S.next(0, cur)) return;
    f32x4 acc[2][2][4][2];
#pragma unroll
    for (int a = 0; a < 2; ++a)
#pragma unroll
        for (int b = 0; b < 2; ++b)
#pragma unroll
            for (int m = 0; m < 4; ++m)
#pragma unroll
                for (int n = 0; n < 2; ++n) acc[a][b][m][n] = (f32x4){0.f, 0.f, 0.f, 0.f};
    bf16x8 At[4][2], B0[2][2], B1[2][2];
    const char* cA = (const char*)g.A + (size_t)cur.pm * tstep; const char* cB = (const char*)g.Bt + (size_t)cur.pn * tstep;
    S.a_ready(cur);
    if constexpr (SP2) {
        PG8_STAGE(PG8_SB(0, 0), cB, voffB); PG8_STAGE(PG8_SB(0, 1), cB + hstep, voffB); PG8_STAGE(PG8_SA(0, 0), cA, voffA); PG8_STAGE(PG8_SA(0, 1), cA + hstep, voffA);
        if (wr == 1) PG8_BAR;
        PG8_WAIT_V(2); PG8_BAR;
        PG8_STAGE(PG8_SB(1, 0), cB + kstep, voffB); PG8_STAGE(PG8_SA(1, 0), cA + kstep, voffA); PG8_STAGE(PG8_SB(1, 1), cB + hstep + kstep, voffB);
        PG8_WAIT_V(6); PG8_BAR;
    } else {
        PG8_STAGE(PG8_SB(0, 0), cB, voffB); PG8_STAGE(PG8_SA(0, 0), cA, voffA); PG8_STAGE(PG8_SB(0, 1), cB + hstep, voffB); PG8_STAGE(PG8_SA(0, 1), cA + hstep, voffA);
        if (wr == 1) PG8_BAR;
        PG8_WAIT_V(4); PG8_BAR;
        PG8_STAGE(PG8_SB(1, 0), cB + kstep, voffB); PG8_STAGE(PG8_SA(1, 0), cA + kstep, voffA); PG8_STAGE(PG8_SB(1, 1), cB + hstep + kstep, voffB);
        PG8_WAIT_V(6); PG8_BAR;
    }
    for (;;) {
        const bool has_next = S.next(ui + 1, nxt);
        const char* nA = has_next ? (const char*)g.A + (size_t)nxt.pm * tstep : cA; const char* nB = has_next ? (const char*)g.Bt + (size_t)nxt.pn * tstep : cB;
        for (int t = 0; t < nt; t += 2) {
            const bool last = (t == nt - 2);
            const char* a1 = cA + (size_t)(t + 1) * kstep;
            const char* a2 = last ? nA : cA + (size_t)(t + 2) * kstep; const char* b2 = last ? nB : cB + (size_t)(t + 2) * kstep;
            const char* a3 = a2 + kstep; const char* b3 = b2 + kstep;
            if (last && has_next) S.a_ready(nxt);
            if constexpr (SP2) {
            PG8_LDB(B0, 0, 0); PG8_LDB(B1, 0, 1); PG8_SCHED; PG8_LDA(At, 0, 0); PG8_STAGE(PG8_SA(1, 1), a1 + hstep, voffA);
            PG8_WAIT_V(8); PG8_WAIT_L(0); PG8_BAR; PG8_MMA(0, 0, At, B0); PG8_MMA(0, 1, At, B1); PG8_BAR; PG8_SCHED;
            PG8_LDA(At, 0, 1); PG8_STAGE(PG8_SB(0, 0), b2, voffB); PG8_STAGE(PG8_SB(0, 1), b2 + hstep, voffB); PG8_STAGE(PG8_SA(0, 0), a2, voffA);
            PG8_WAIT_V(8); PG8_WAIT_L(0); PG8_BAR; PG8_MMA(1, 0, At, B0); PG8_MMA(1, 1, At, B1); PG8_BAR; PG8_SCHED;
            PG8_LDB(B0, 1, 0); PG8_LDB(B1, 1, 1); PG8_SCHED; PG8_LDA(At, 1, 0); PG8_STAGE(PG8_SA(0, 1), a2 + hstep, voffA);
            PG8_WAIT_V(8); PG8_WAIT_L(0); PG8_BAR; PG8_MMA(0, 0, At, B0); PG8_MMA(0, 1, At, B1); PG8_BAR; PG8_SCHED;
            PG8_LDA(At, 1, 1); PG8_STAGE(PG8_SB(1, 0), b3, voffB); PG8_STAGE(PG8_SB(1, 1), b3 + hstep, voffB); PG8_STAGE(PG8_SA(1, 0), a3, voffA);
            PG8_WAIT_V(8); PG8_WAIT_L(0); PG8_BAR; PG8_MMA(1, 0, At, B0); PG8_MMA(1, 1, At, B1); PG8_BAR; PG8_SCHED;
            } else {
            PG8_LDB(B0, 0, 0); PG8_SCHED; PG8_LDA(At, 0, 0); PG8_STAGE(PG8_SA(1, 1), a1 + hstep, voffA);
            PG8_WAIT_L(8); PG8_BAR; PG8_WAIT_L(0); PG8_MMA(0, 0, At, B0); PG8_BAR; PG8_SCHED;
            PG8_LDB(B1, 0, 1); PG8_STAGE(PG8_SB(0, 0), b2, voffB);
            PG8_BAR; PG8_WAIT_L(0); PG8_MMA(0, 1, At, B1); PG8_BAR;
            PG8_LDA(At, 0, 1); PG8_STAGE(PG8_SA(0, 0), a2, voffA);
            PG8_BAR; PG8_WAIT_L(0); PG8_MMA(1, 0, At, B0); PG8_BAR; PG8_SCHED;
            PG8_STAGE(PG8_SB(0, 1), b2 + hstep, voffB);
            PG8_WAIT_V(6); PG8_BAR; PG8_MMA(1, 1, At, B1); PG8_BAR;
            PG8_LDB(B0, 1, 0); PG8_SCHED; PG8_LDA(At, 1, 0); PG8_STAGE(PG8_SA(0, 1), a2 + hstep, voffA);
            PG8_WAIT_L(8); PG8_BAR; PG8_WAIT_L(0); PG8_MMA(0, 0, At, B0); PG8_BAR; PG8_SCHED;
            PG8_LDB(B1, 1, 1); PG8_STAGE(PG8_SB(1, 0), b3, voffB);
            PG8_BAR; PG8_WAIT_L(0); PG8_MMA(0, 1, At, B1); PG8_BAR;
            PG8_LDA(At, 1, 1); PG8_STAGE(PG8_SA(1, 0), a3, voffA);
            PG8_BAR; PG8_WAIT_L(0); PG8_MMA(1, 0, At, B0); PG8_BAR; PG8_SCHED;
            PG8_STAGE(PG8_SB(1, 1), b3 + hstep, voffB);
            PG8_WAIT_V(6); PG8_BAR; PG8_MMA(1, 1, At, B1); PG8_BAR;
            }
        }
        if constexpr (ALIGN_EPI) { if (wr == 0) PG8_BAR; }
        if constexpr (!Epi::AFTER_DRAIN) { E(acc, cur, wr, wc, fr, fq); S.done(cur); }
        if (!has_next) break;
#pragma unroll
        for (int a = 0; a < 2; ++a)
#pragma unroll
            for (int b = 0; b < 2; ++b)
#pragma unroll
                for (int m = 0; m < 4; ++m)
#pragma unroll
                    for (int n = 0; n < 2; ++n) acc[a][b][m][n] = (f32x4){0.f, 0.f, 0.f, 0.f};
        cur = nxt; cA = nA; cB = nB; ++ui;
        if constexpr (ALIGN_EPI) { if (wr == 1) PG8_BAR; }
    }
    PG8_WAIT_V(0);
    if constexpr (!ALIGN_EPI) { if (wr == 0) PG8_BAR; }
    PG8_BAR;
    if constexpr (Epi::AFTER_DRAIN) { E.fused(acc, cur, wr, wc, fr, fq, lds, wid, lane); S.done(cur); }
#undef PG8_SA
#undef PG8_SB
#undef PG8_STAGE
#undef PG8_LDA
#undef PG8_LDB
#undef PG8_MMA
#undef PG8_WAIT_V
#undef PG8_WAIT_L
#undef PG8_BAR
#undef PG8_SCHED
}
}
#define GAS __attribute__((address_space(1)))
#define LAS __attribute__((address_space(3)))
typedef unsigned short bf16;
typedef unsigned v4u __attribute__((ext_vector_type(4)));
typedef float f32x4 __attribute__((ext_vector_type(4)));
typedef short bf16x8 __attribute__((ext_vector_type(8)));
typedef GAS unsigned gu32;
typedef GAS unsigned long long gu64;
#define RLX_AGENT __ATOMIC_RELAXED, __HIP_MEMORY_SCOPE_AGENT
#define LDS_WAIT() asm volatile("s_waitcnt lgkmcnt(0)" ::: "memory")
#define VM_WAIT() asm volatile("s_waitcnt vmcnt(0)" ::: "memory")
__device__ __forceinline__ unsigned long long rt() { return __builtin_amdgcn_s_memrealtime(); }
__device__ __forceinline__ unsigned f2bf(float f) { unsigned u = __builtin_bit_cast(unsigned, f); return (u + 0x7fffu + ((u >> 16) & 1u)) >> 16; }
__device__ __forceinline__ unsigned pk2(float lo, float hi) { return f2bf(lo) | (f2bf(hi) << 16); }

#define XB_TMO      128
#define XB_XCNT(j)  (256  + 64 * (j))
#define XB_XSUB(j)  (1280 + 64 * (j))
#define XB_XGEN(j)  (2304 + 64 * (j))
#define XB_TOP      3328
#define XB_TOPGEN   3392
#define XCD_BAR_WORDS 3456
#define XB_SPIN_CAP (1u << 18)

__device__ __forceinline__ unsigned xb_ld(unsigned* p)              { return __hip_atomic_load(p, __ATOMIC_RELAXED, __HIP_MEMORY_SCOPE_AGENT); }
__device__ __forceinline__ unsigned xb_add(unsigned* p, unsigned v) { return __hip_atomic_fetch_add(p, v, __ATOMIC_RELAXED, __HIP_MEMORY_SCOPE_AGENT); }
__device__ __forceinline__ unsigned xb_xcc_id() { return (unsigned)__builtin_amdgcn_s_getreg((3 << 11) | 20) & 0xFu; }
#define XB_SPIN(cond, bar) do { unsigned _sp = 0; while (cond) { __builtin_amdgcn_s_sleep(1); \
    if ((++_sp & 255u) == 0u) { if (xb_ld(&(bar)[XB_TMO])) break; if (_sp > XB_SPIN_CAP) { atomicAdd(&(bar)[XB_TMO], 1u); break; } } } } while (0)

struct XcdBarrier {
    unsigned* bar; unsigned x;
    volatile LAS unsigned* st;
};

__device__ __forceinline__ XcdBarrier xcd_barrier_post(unsigned* bar, volatile LAS unsigned* st) {
    XcdBarrier b; b.bar = bar; b.x = xb_xcc_id(); b.st = st;
    if (threadIdx.x == 0) (void)xb_add(&bar[XB_XCNT(b.x)], 1u);
    return b;
}
__device__ __forceinline__ void xcd_barrier_complete(unsigned* bar, unsigned x, unsigned& nloc, unsigned& nx) {
    const unsigned G = gridDim.x * gridDim.y * gridDim.z;
    unsigned sum, cnt, mine, sp = 0u;
    for (;;) {
        sum = 0u; cnt = 0u; mine = 0u;
#pragma unroll
        for (unsigned j = 0; j < 16; ++j) { const unsigned c = xb_ld(&bar[XB_XCNT(j)]); sum += c; cnt += (c > 0u) ? 1u : 0u; mine = (j == x) ? c : mine; }
        if (sum == G) break;
        __builtin_amdgcn_s_sleep(1);
        if ((++sp & 255u) == 0u) { if (xb_ld(&bar[XB_TMO])) break; if (sp > XB_SPIN_CAP) { atomicAdd(&bar[XB_TMO], 1u); break; } }
    }
    nloc = mine > 0u ? mine : 1u; nx = cnt > 0u ? cnt : 1u;
}

__device__ __forceinline__ void xcd_barrier(const XcdBarrier& b) {
    asm volatile("s_waitcnt vmcnt(0)" ::: "memory");
    __syncthreads();
    if (threadIdx.x == 0) {
        unsigned* bar = b.bar;
        __builtin_amdgcn_s_waitcnt(0);
        unsigned nloc = b.st[0], nx = b.st[1];
        if (nloc == 0u) { xcd_barrier_complete(bar, b.x, nloc, nx); b.st[0] = nloc; b.st[1] = nx; }
        const unsigned old = xb_add(&bar[XB_XSUB(b.x)], 1u);
        const unsigned gen = old / nloc;
        if (old + 1u == (gen + 1u) * nloc) {
            __builtin_amdgcn_fence(__ATOMIC_RELEASE, "agent");
            asm volatile("s_waitcnt vmcnt(0)" ::: "memory");
            const unsigned og = xb_add(&bar[XB_TOP], 1u);
            const unsigned tg = og / nx;
            if (og + 1u == (tg + 1u) * nx) xb_add(&bar[XB_TOPGEN], 1u);
            else XB_SPIN(xb_ld(&bar[XB_TOPGEN]) == tg, bar);
            __builtin_amdgcn_fence(__ATOMIC_ACQUIRE, "agent");
            xb_add(&bar[XB_XGEN(b.x)], 1u);
            asm volatile("s_waitcnt vmcnt(0)" ::: "memory");
        } else {
            XB_SPIN(xb_ld(&bar[XB_XGEN(b.x)]) == gen, bar);
            __builtin_amdgcn_fence(__ATOMIC_ACQUIRE, "agent");
            asm volatile("s_waitcnt vmcnt(0)" ::: "memory");
        }
    }
    __syncthreads();
}

constexpr int NWAVES = 8;
constexpr int BATCH = 2, SEQ = 4096, DM = 4096, M = BATCH * SEQ;
constexpr int NH = 64, NKV = 8, HD = 64, QKVW = 5120;
constexpr int FF = 11008, NUP = 2 * FF;
constexpr int SG = 256, SGC = 16, SP = 64;
constexpr float EPS = 1e-6f;
#ifndef MK_N_LAUNCHES
#define MK_N_LAUNCHES 16
#endif
constexpr int N_PHASES = 16;
constexpr int N_LAUNCHES = MK_N_LAUNCHES;

constexpr size_t MiB = 1u << 20;
constexpr size_t WS_CTL = 0, CTL_ZERO_BYTES = 1 * MiB;
constexpr size_t WS_WQKV = 2 * MiB;
constexpr size_t WS_WO   = WS_WQKV + 40 * MiB;
constexpr size_t WS_WUP0 = WS_WO + 32 * MiB;
constexpr size_t WS_WUP1 = WS_WUP0 + 172 * MiB;
constexpr size_t WS_WDN0 = WS_WUP1 + 172 * MiB;
constexpr size_t WS_WDN1 = WS_WDN0 + 86 * MiB;
constexpr size_t WS_WGLU = WS_WDN1 + 86 * MiB;
constexpr size_t WS_X    = WS_WGLU + 64 * MiB;
constexpr size_t WS_XN   = WS_X + 128 * MiB;
constexpr size_t WS_QKV  = WS_XN + 64 * MiB;
constexpr size_t WS_AO   = WS_QKV + 80 * MiB;
constexpr size_t WS_ACT  = WS_AO + 64 * MiB;
constexpr size_t WS_HEAD = WS_ACT + 172 * MiB;
constexpr size_t WS_TAIL = WS_HEAD + 22 * MiB;
constexpr size_t WS_END  = WS_TAIL + 22 * MiB;
static_assert((size_t)NUP * DM * 2 <= 172 * MiB && (size_t)DM * FF * 2 <= 86 * MiB && (size_t)M * FF * 2 <= 172 * MiB && (size_t)(M / 64) * 2 * NUP * 4 <= 22 * MiB, "ws map");
constexpr int CW_BAR = 4096;

constexpr int RING_OFF = 0, RING_BYTES = 131072;
constexpr int LDSCTL_OFF = RING_BYTES, MISC_OFF = LDSCTL_OFF + 320;
constexpr int LDS_BYTES = 147456;
static_assert(MISC_OFF + 128 <= LDS_BYTES, "LDS map");

struct Frame {
    LAS unsigned char* lds;
    volatile LAS unsigned* MISC;
    gu32* ctl;
    int tid, lane, wave;
    int vcu, G;
};
__device__ __forceinline__ float wave_sum(float v) {
#pragma unroll
    for (int o = 1; o < 64; o <<= 1) v += __shfl_xor(v, o);
    return v;
}
__device__ __forceinline__ float bf_lo(unsigned w) { return __uint_as_float(w << 16); }
__device__ __forceinline__ float bf_hi(unsigned w) { return __uint_as_float(w & 0xffff0000u); }

__device__ __forceinline__ int rowmap(int n, int Hh) { if (Hh == 0) return n; const int half = n >= Hh ? 1 : 0; const int f = n - half * Hh; return ((f >> 7) << 8) + (half << 7) + (f & 127); }
__device__ __forceinline__ void p0_transpose_item(const float* W, int K, int N, bf16* WT, int Hh, LAS float* scr, int item, int lane) {
    const int nblk = N / 32, kb = item / nblk, nb = item % nblk, k0 = 64 * kb, n0 = 32 * nb;
#pragma unroll 8
    for (int i = 0; i < 32; ++i) { const int kk = 2 * i + (lane >> 5); scr[kk * 33 + (lane & 31)] = W[(size_t)(k0 + kk) * N + n0 + (lane & 31)]; }
    LDS_WAIT(); asm volatile("" ::: "memory");
    const int c = lane & 7; const int r0 = rowmap(n0, Hh);
#pragma unroll
    for (int j = 0; j < 4; ++j) { const int n = (lane >> 3) + 8 * j; const LAS float* s = scr + (8 * c) * 33 + n;
        v4u o; o.x = pk2(s[0 * 33], s[1 * 33]); o.y = pk2(s[2 * 33], s[3 * 33]); o.z = pk2(s[4 * 33], s[5 * 33]); o.w = pk2(s[6 * 33], s[7 * 33]);
        *(GAS v4u*)(WT + (size_t)(r0 + n) * K + k0 + 8 * c) = o; }
    LDS_WAIT(); asm volatile("" ::: "memory");
}
__device__ __forceinline__ void convert_weights(Frame& F, const float* const* in, unsigned char* ws) {
    LAS float* scr = (LAS float*)(F.lds + RING_OFF + F.wave * 16384);
    const int gw = F.vcu * NWAVES + F.wave, NGW = F.G * NWAVES;
    constexpr int I_QKV = (DM / 64) * (QKVW / 32), I_O = (DM / 64) * (DM / 32), I_UP = (DM / 64) * (NUP / 32), I_DN = (FF / 64) * (DM / 32), I_GLU = (DM / 64) * (2 * DM / 32);
    constexpr int NITEMS = I_QKV + I_O + 2 * I_UP + 2 * I_DN + I_GLU;
    for (int it = gw; it < NITEMS; it += NGW) {
        int r = it;
        if (r < I_QKV) { p0_transpose_item(in[2], DM, QKVW, (bf16*)(ws + WS_WQKV), 0, scr, r, F.lane); continue; } r -= I_QKV;
        if (r < I_O)   { p0_transpose_item(in[3], DM, DM, (bf16*)(ws + WS_WO), 0, scr, r, F.lane); continue; } r -= I_O;
        if (r < I_UP)  { p0_transpose_item(in[17], DM, NUP, (bf16*)(ws + WS_WUP0), FF, scr, r, F.lane); continue; } r -= I_UP;
        if (r < I_UP)  { p0_transpose_item(in[17] + (size_t)DM * NUP, DM, NUP, (bf16*)(ws + WS_WUP1), FF, scr, r, F.lane); continue; } r -= I_UP;
        if (r < I_DN)  { p0_transpose_item(in[20], FF, DM, (bf16*)(ws + WS_WDN0), 0, scr, r, F.lane); continue; } r -= I_DN;
        if (r < I_DN)  { p0_transpose_item(in[20] + (size_t)FF * DM, FF, DM, (bf16*)(ws + WS_WDN1), 0, scr, r, F.lane); continue; } r -= I_DN;
        p0_transpose_item(in[15], DM, 2 * DM, (bf16*)(ws + WS_WGLU), DM, scr, r, F.lane);
    }
}
template <bool OUT_BF16>
__device__ __forceinline__ void norm_rows(Frame& F, const float* src, const float* gain, void* dst) {
    const int gw = F.vcu * NWAVES + F.wave, NGW = F.G * NWAVES;
    for (int m = gw; m < M; m += NGW) {
        const GAS f32x4* xr = (const GAS f32x4*)(src + (size_t)m * DM) + F.lane;
        f32x4 v[16]; float s = 0.f;
#pragma unroll
        for (int j = 0; j < 16; ++j) { v[j] = xr[64 * j]; s += (v[j].x * v[j].x + v[j].y * v[j].y) + (v[j].z * v[j].z + v[j].w * v[j].w); }
        const float rstd = 1.0f / sqrtf(wave_sum(s) * (1.0f / DM) + EPS);
        const GAS f32x4* gr = (const GAS f32x4*)gain + F.lane;
        if (OUT_BF16) {
            GAS unsigned long long* o8 = (GAS unsigned long long*)((bf16*)dst + (size_t)m * DM) + F.lane;
#pragma unroll
            for (int j = 0; j < 16; ++j) { const f32x4 g = gr[64 * j]; o8[64 * j] = (unsigned long long)pk2(v[j].x * rstd * g.x, v[j].y * rstd * g.y) | ((unsigned long long)pk2(v[j].z * rstd * g.z, v[j].w * rstd * g.w) << 32); }
        } else {
            GAS f32x4* o = (GAS f32x4*)((float*)dst + (size_t)m * DM) + F.lane;
#pragma unroll
            for (int j = 0; j < 16; ++j) { const f32x4 g = gr[64 * j]; f32x4 r; r.x = v[j].x * rstd * g.x; r.y = v[j].y * rstd * g.y; r.z = v[j].z * rstd * g.z; r.w = v[j].w * rstd * g.w; o[64 * j] = r; }
        }
    }
}
__device__ __forceinline__ int t5_bucket(int n) { if (n < 16) return n; const int b = 16 + (int)(__log2f((float)n * 0.0625f) * (16.0f / 3.0f)); return b < 31 ? b : 31; }

__device__ __forceinline__ void attn_naive(Frame& F, const bf16* QKV, const float* sinks, const float* rel_bias, bf16* AO) {
    const int gw = F.vcu * NWAVES + F.wave, NGW = F.G * NWAVES;
    for (int task = gw; task < 8192; task += NGW) {
        const int h = task & 63, rest = task >> 6, half = rest & 1, nb = (rest >> 1) & 31, b = rest >> 6;
        const int i0 = half * 64, qpos = nb * 128 + i0 + F.lane; const size_t qrow = (size_t)b * SEQ + qpos;
        float q[64], o[64];
        { const uint4* qp = (const uint4*)(QKV + qrow * QKVW + h * 64);
#pragma unroll
          for (int j = 0; j < 8; ++j) { const uint4 w = qp[j]; q[8 * j] = bf_lo(w.x); q[8 * j + 1] = bf_hi(w.x); q[8 * j + 2] = bf_lo(w.y); q[8 * j + 3] = bf_hi(w.y); q[8 * j + 4] = bf_lo(w.z); q[8 * j + 5] = bf_hi(w.z); q[8 * j + 6] = bf_lo(w.w); q[8 * j + 7] = bf_hi(w.w); } }
#pragma unroll
        for (int j = 0; j < 64; ++j) o[j] = 0.f;
        float mx = sinks[h], l = 1.0f;
        const int kvh = h >> 3, kstart = nb * 128 + i0 - 127;
        for (int jj = 0; jj < 191; ++jj) {
            const int kpos = kstart + jj; if (kpos < 0) continue;
            const int dist = F.lane + 127 - jj; const bool valid = dist >= 0 && dist < 128;
            const uint4* kp = (const uint4*)(QKV + ((size_t)b * SEQ + kpos) * QKVW + DM + kvh * 64);
            float dot = 0.f;
#pragma unroll
            for (int j = 0; j < 8; ++j) { const uint4 w = kp[j];
                dot += q[8 * j] * bf_lo(w.x) + q[8 * j + 1] * bf_hi(w.x) + q[8 * j + 2] * bf_lo(w.y) + q[8 * j + 3] * bf_hi(w.y) + q[8 * j + 4] * bf_lo(w.z) + q[8 * j + 5] * bf_hi(w.z) + q[8 * j + 6] * bf_lo(w.w) + q[8 * j + 7] * bf_hi(w.w); }
            if (valid) {
                const float s = dot * 0.125f + rel_bias[t5_bucket(dist) * NH + h];
                const float mn = fmaxf(mx, s), corr = __expf(mx - mn), p = __expf(s - mn);
                l = l * corr + p; mx = mn;
                const uint4* vp = kp + 64;
#pragma unroll
                for (int j = 0; j < 8; ++j) { const uint4 w = vp[j];
                    o[8 * j] = o[8 * j] * corr + p * bf_lo(w.x); o[8 * j + 1] = o[8 * j + 1] * corr + p * bf_hi(w.x); o[8 * j + 2] = o[8 * j + 2] * corr + p * bf_lo(w.y); o[8 * j + 3] = o[8 * j + 3] * corr + p * bf_hi(w.y);
                    o[8 * j + 4] = o[8 * j + 4] * corr + p * bf_lo(w.z); o[8 * j + 5] = o[8 * j + 5] * corr + p * bf_hi(w.z); o[8 * j + 6] = o[8 * j + 6] * corr + p * bf_lo(w.w); o[8 * j + 7] = o[8 * j + 7] * corr + p * bf_hi(w.w); }
            }
        }
        const float inv = 1.0f / l;
        v4u* op = (v4u*)(AO + qrow * DM + h * 64);
#pragma unroll
        for (int j = 0; j < 8; ++j) { v4u w; w.x = pk2(o[8 * j] * inv, o[8 * j + 1] * inv); w.y = pk2(o[8 * j + 2] * inv, o[8 * j + 3] * inv); w.z = pk2(o[8 * j + 4] * inv, o[8 * j + 5] * inv); w.w = pk2(o[8 * j + 6] * inv, o[8 * j + 7] * inv); op[j] = w; }
    }
}
__device__ __forceinline__ float gelu_tanh(float x) {
    const float z = 0.7978845608028654f * (x + 0.044715f * x * x * x);
    return x * __builtin_amdgcn_rcpf(1.0f + __builtin_amdgcn_exp2f(-2.0f * 1.4426950408889634f * z));
}
__device__ __forceinline__ void s5_naive(Frame& F, const bf16* H, const float* lam_re, const float* lam_im, const float* log_step, const float* b_re, const float* b_im,
                                         const float* c_re, const float* c_im, const float* d_skip, bf16* YG) {
    if (F.wave < 2) {
        const int task = (int)blockIdx.x * 2 + F.wave;
        if (task < 2 * SG) {
            const int g = task >> 1, b = task & 1, p = F.lane;
            const float delta = expf(log_step[g]), lr = lam_re[g * SP + p], li = lam_im[g * SP + p];
            const float mag = expf(lr * delta); float sn, cs; sincosf(li * delta, &sn, &cs);
            const float ar = mag * cs, ai = mag * sn, nr = ar - 1.0f, ni = ai, den = lr * lr + li * li;
            const float fr = (nr * lr + ni * li) / den, fi = (ni * lr - nr * li) / den;
            float br[16], bi[16], cr[16], ci[16];
#pragma unroll
            for (int c = 0; c < 16; ++c) { const float Br = b_re[(size_t)(g * SP + p) * SGC + c], Bi = b_im[(size_t)(g * SP + p) * SGC + c];
                br[c] = fr * Br - fi * Bi; bi[c] = fr * Bi + fi * Br; cr[c] = c_re[(size_t)(g * SGC + c) * SP + p]; ci[c] = c_im[(size_t)(g * SGC + c) * SP + p]; }
            const int cw = F.lane >> 2; const float dsk = d_skip[g * SGC + cw];
            const bool b5 = (F.lane & 32) != 0, b4 = (F.lane & 16) != 0, b3 = (F.lane & 8) != 0, b2 = (F.lane & 4) != 0;
            float xr = 0.f, xi = 0.f;
            for (int t = 0; t < SEQ; ++t) {
                const size_t row = (size_t)b * SEQ + t;
                const uint4* up = (const uint4*)(H + row * DM + g * SGC); const uint4 wa = up[0], wb = up[1];
                float u[16]; u[0] = bf_lo(wa.x); u[1] = bf_hi(wa.x); u[2] = bf_lo(wa.y); u[3] = bf_hi(wa.y); u[4] = bf_lo(wa.z); u[5] = bf_hi(wa.z); u[6] = bf_lo(wa.w); u[7] = bf_hi(wa.w);
                u[8] = bf_lo(wb.x); u[9] = bf_hi(wb.x); u[10] = bf_lo(wb.y); u[11] = bf_hi(wb.y); u[12] = bf_lo(wb.z); u[13] = bf_hi(wb.z); u[14] = bf_lo(wb.w); u[15] = bf_hi(wb.w);
                float bur = 0.f, bui = 0.f;
#pragma unroll
                for (int c = 0; c < 16; ++c) { bur += br[c] * u[c]; bui += bi[c] * u[c]; }
                const float nxr = ar * xr - ai * xi + bur, nxi = ar * xi + ai * xr + bui; xr = nxr; xi = nxi;
                float v[16];
#pragma unroll
                for (int c = 0; c < 16; ++c) v[c] = cr[c] * xr - ci[c] * xi;
                float w8[8], w4[4], w2[2];
#pragma unroll
                for (int k = 0; k < 8; ++k) { const float send = b5 ? v[k] : v[k + 8], keep = b5 ? v[k + 8] : v[k]; w8[k] = keep + __shfl_xor(send, 32); }
#pragma unroll
                for (int k = 0; k < 4; ++k) { const float send = b4 ? w8[k] : w8[k + 4], keep = b4 ? w8[k + 4] : w8[k]; w4[k] = keep + __shfl_xor(send, 16); }
#pragma unroll
                for (int k = 0; k < 2; ++k) { const float send = b3 ? w4[k] : w4[k + 2], keep = b3 ? w4[k + 2] : w4[k]; w2[k] = keep + __shfl_xor(send, 8); }
                float y; { const float send = b2 ? w2[0] : w2[1], keep = b2 ? w2[1] : w2[0]; y = keep + __shfl_xor(send, 4); }
                y += __shfl_xor(y, 1); y += __shfl_xor(y, 2);
                if ((F.lane & 3) == 0) {
                    const float uc = __uint_as_float(((unsigned)H[row * DM + g * SGC + cw]) << 16);
                    const float yy = gelu_tanh(y + dsk * uc);
                    YG[row * DM + g * SGC + cw] = (bf16)f2bf(yy);
                }
            }
        }
    }
}
__device__ __forceinline__ void conv_fixup(Frame& F, const float* HEAD, const float* TAIL, const float* cw, const float* cb, bf16* ACT) {
    const int gt = F.vcu * NWAVES * 64 + F.tid, NGT = F.G * NWAVES * 64;
    for (int it = gt; it < (M / 64) * FF; it += NGT) {
        const int blk = it / FF, f = it - blk * FF;
        const int nn = ((f >> 7) << 8) + (f & 127);
        float c0[2], c1[2];
#pragma unroll
        for (int bj = 0; bj < 2; ++bj) {
            const int col = bj * FF + f, nc = nn + bj * 128;
            const float w0 = cw[col], w1 = cw[NUP + col], w2 = cw[2 * NUP + col], bb = cb[col];
            float t0 = 0.f, t1 = 0.f;
            if ((blk & 63) != 0) { t0 = TAIL[((size_t)(blk - 1) * 2 + 0) * NUP + nc]; t1 = TAIL[((size_t)(blk - 1) * 2 + 1) * NUP + nc]; }
            const float h0 = HEAD[((size_t)blk * 2 + 0) * NUP + nc], h1 = HEAD[((size_t)blk * 2 + 1) * NUP + nc];
            c0[bj] = bb + w0 * t0 + w1 * t1 + w2 * h0;
            c1[bj] = bb + w0 * t1 + w1 * h0 + w2 * h1;
        }
        const float o0 = c0[0] * pg8::fast_sigmoid(c0[0]) * c0[1], o1 = c1[0] * pg8::fast_sigmoid(c1[0]) * c1[1];
        ACT[(size_t)(blk * 64) * FF + f] = (bf16)f2bf(o0);
        ACT[(size_t)(blk * 64 + 1) * FF + f] = (bf16)f2bf(o1);
    }
}

struct Args { const float* in[22]; float* out; unsigned char* ws; int ph_lo, ph_hi, li, pad; };
__global__ void __launch_bounds__(NWAVES * 64, 2) mk_fwd(Args args) {
    extern __shared__ __attribute__((aligned(16))) unsigned char lds[];
    Frame F;
    F.lds = (LAS unsigned char*)lds;
    F.MISC = (volatile LAS unsigned*)(F.lds + MISC_OFF);
    F.tid = threadIdx.x; F.lane = F.tid & 63; F.wave = __builtin_amdgcn_readfirstlane(F.tid >> 6);
    F.G = gridDim.x; { const int bx = blockIdx.x; F.vcu = (F.G % 8 == 0) ? (bx % 8) * (F.G / 8) + bx / 8 : bx; }
    unsigned char* ws = args.ws;
    F.ctl = (gu32*)(ws + WS_CTL);
    for (int u = F.tid; u < (LDS_BYTES - LDSCTL_OFF) / 4; u += NWAVES * 64) ((LAS unsigned*)(F.lds + LDSCTL_OFF))[u] = 0u;
    __syncthreads();
    XcdBarrier bar; bar.bar = (unsigned*)(F.ctl + CW_BAR); bar.x = 0; bar.st = nullptr;
    if (N_LAUNCHES == 1) bar = xcd_barrier_post((unsigned*)(F.ctl + CW_BAR), F.MISC + 8);
#define GRID_BAR() do { if (N_LAUNCHES == 1) xcd_barrier(bar); } while (0)
    const int lo = args.ph_lo, hi = args.ph_hi;
#define IN(k) (lo <= (k) && (k) < hi)
#define BOTH(k) (IN(k) && IN((k) + 1))
    const float* x_in = args.in[0];
    float* X = (float*)(ws + WS_X);
    bf16* XN = (bf16*)(ws + WS_XN); bf16* QKV = (bf16*)(ws + WS_QKV); bf16* AO = (bf16*)(ws + WS_AO); bf16* ACT = (bf16*)(ws + WS_ACT);
    float* HEAD = (float*)(ws + WS_HEAD); float* TAIL = (float*)(ws + WS_TAIL);

    if (IN(0)) { convert_weights(F, args.in, ws); norm_rows<true>(F, x_in, args.in[1], XN); if (BOTH(0)) GRID_BAR(); }
    if (IN(1)) { pg8::Gemm g{XN, (const bf16*)(ws + WS_WQKV), M, QKVW, DM}; pg8::StaticOrder S; S.init(M, QKVW, F.G, (int)blockIdx.x);
        pg8::EpiBf16 E{QKV, QKVW};
        pg8::gemm_phase<pg8::EpiBf16, pg8::StaticOrder, true, true>(F.lds + RING_OFF, g, S, E);
        if (BOTH(1)) GRID_BAR(); }
    if (IN(2)) { attn_naive(F, QKV, args.in[4], args.in[5], AO); if (BOTH(2)) GRID_BAR(); }
    if (IN(3)) { pg8::Gemm g{AO, (const bf16*)(ws + WS_WO), M, DM, DM}; pg8::StaticOrder S; S.init(M, DM, F.G, (int)blockIdx.x);
        pg8::EpiResF32 E{x_in, X, DM};
        pg8::gemm_phase<pg8::EpiResF32, pg8::StaticOrder, true, true>(F.lds + RING_OFF, g, S, E);
        if (BOTH(3)) GRID_BAR(); }
    if (IN(4)) { norm_rows<true>(F, X, args.in[16], XN); if (BOTH(4)) GRID_BAR(); }
    if (IN(5)) { pg8::Gemm g{XN, (const bf16*)(ws + WS_WUP0), M, NUP, DM}; pg8::StaticOrder S; S.init(M, NUP, F.G, (int)blockIdx.x);
        pg8::EpiConvGate E{ACT, FF, HEAD, TAIL, args.in[18], args.in[19], FF, NUP};
        pg8::gemm_phase<pg8::EpiConvGate, pg8::StaticOrder, true, true>(F.lds + RING_OFF, g, S, E);
        if (BOTH(5)) GRID_BAR(); }
    if (IN(6)) { conv_fixup(F, HEAD, TAIL, args.in[18], args.in[19], ACT); if (BOTH(6)) GRID_BAR(); }
    if (IN(7)) { pg8::Gemm g{ACT, (const bf16*)(ws + WS_WDN0), M, DM, FF}; pg8::StaticOrder S; S.init(M, DM, F.G, (int)blockIdx.x);
        pg8::EpiResF32 E{X, X, DM};
        pg8::gemm_phase<pg8::EpiResF32, pg8::StaticOrder, true, true>(F.lds + RING_OFF, g, S, E);
        if (BOTH(7)) GRID_BAR(); }
    if (IN(8)) { norm_rows<true>(F, X, args.in[6], XN); if (BOTH(8)) GRID_BAR(); }
    if (IN(9)) { s5_naive(F, XN, args.in[7], args.in[8], args.in[9], args.in[10], args.in[11], args.in[12], args.in[13], args.in[14], AO); if (BOTH(9)) GRID_BAR(); }
    if (IN(10)) { pg8::Gemm g{AO, (const bf16*)(ws + WS_WGLU), M, 2 * DM, DM}; pg8::StaticOrder S; S.init(M, 2 * DM, F.G, (int)blockIdx.x);
        pg8::EpiGluRes E{X, DM};
        pg8::gemm_phase<pg8::EpiGluRes, pg8::StaticOrder, true, true>(F.lds + RING_OFF, g, S, E);
        if (BOTH(10)) GRID_BAR(); }
    if (IN(11)) { norm_rows<true>(F, X, args.in[16] + DM, XN); if (BOTH(11)) GRID_BAR(); }
    if (IN(12)) { pg8::Gemm g{XN, (const bf16*)(ws + WS_WUP1), M, NUP, DM}; pg8::StaticOrder S; S.init(M, NUP, F.G, (int)blockIdx.x);
        pg8::EpiConvGate E{ACT, FF, HEAD, TAIL, args.in[18] + 3 * NUP, args.in[19] + NUP, FF, NUP};
        pg8::gemm_phase<pg8::EpiConvGate, pg8::StaticOrder, true, true>(F.lds + RING_OFF, g, S, E);
        if (BOTH(12)) GRID_BAR(); }
    if (IN(13)) { conv_fixup(F, HEAD, TAIL, args.in[18] + 3 * NUP, args.in[19] + NUP, ACT); if (BOTH(13)) GRID_BAR(); }
    if (IN(14)) { pg8::Gemm g{ACT, (const bf16*)(ws + WS_WDN1), M, DM, FF}; pg8::StaticOrder S; S.init(M, DM, F.G, (int)blockIdx.x);
        pg8::EpiResF32 E{X, X, DM};
        pg8::gemm_phase<pg8::EpiResF32, pg8::StaticOrder, true, true>(F.lds + RING_OFF, g, S, E);
        if (BOTH(14)) GRID_BAR(); }
    if (IN(15)) { norm_rows<false>(F, X, args.in[21], args.out); }
#undef IN
#undef BOTH
}

extern "C" void kernel_launch(void* const* d_in, const int* in_sizes, int n_in, void* d_out, int out_size, void* d_ws, size_t ws_size, hipStream_t stream) {
    static int grid = 0;
    if (grid == 0) {
        if (n_in != 22 || out_size != M * DM || ws_size < WS_END) { fprintf(stderr, "kernel_launch: unexpected shapes (n_in %d, out %d, ws %zu < %zu)\n", n_in, out_size, ws_size, (size_t)WS_END); grid = -1; return; }
        int dev = 0, cus = 0, per_cu = 0;
        if (hipGetDevice(&dev) != hipSuccess || hipDeviceGetAttribute(&cus, hipDeviceAttributeMultiprocessorCount, dev) != hipSuccess) { grid = -1; return; }
        if (hipFuncSetAttribute((const void*)mk_fwd, hipFuncAttributeMaxDynamicSharedMemorySize, LDS_BYTES) != hipSuccess) { fprintf(stderr, "kernel_launch: hipFuncSetAttribute failed\n"); grid = -1; return; }
        if (hipOccupancyMaxActiveBlocksPerMultiprocessor(&per_cu, (const void*)mk_fwd, NWAVES * 64, LDS_BYTES) != hipSuccess || per_cu < 1) { fprintf(stderr, "kernel_launch: occupancy query reports %d\n", per_cu); }
        (void)hipGetLastError();
        grid = cus;
    }
    if (grid < 0) return;
    if (hipMemsetAsync((char*)d_ws + WS_CTL, 0, CTL_ZERO_BYTES, stream) != hipSuccess) return;
    Args a{};
    for (int i = 0; i < 22; ++i) a.in[i] = (const float*)d_in[i];
    a.out = (float*)d_out; a.ws = (unsigned char*)d_ws;
    for (int li = 0; li < N_LAUNCHES; ++li) {
        if (N_LAUNCHES == 1) { a.ph_lo = 0; a.ph_hi = N_PHASES; } else { a.ph_lo = li; a.ph_hi = li + 1; }
        a.li = li; a.pad = 0;
        hipLaunchKernelGGL(mk_fwd, dim3(grid), dim3(NWAVES * 64), LDS_BYTES, stream, a);
    }
}
```

```cpp
#include <hip/hip_runtime.h>
#include <cstdio>
#include <cstdint>
namespace pg8 {
#define PG8_LAS __attribute__((address_space(3)))
typedef unsigned short bf16_t;
typedef short bf16x8 __attribute__((ext_vector_type(8)));
typedef float f32x4 __attribute__((ext_vector_type(4)));
typedef int i32x4 __attribute__((ext_vector_type(4)));
typedef unsigned u32x4 __attribute__((ext_vector_type(4)));
constexpr int BM = 256, BK = 64, HALF = 128, HTB = HALF * BK * 2  , STAGE_BYTES = 8 * HTB, NXCD = 8, WGM = 8;

__host__ __device__ __forceinline__ int lds_byte(int r, int c) { const int st = (r >> 4) * 2 + (c >> 5), rr = r & 15, cc = c & 31, ob = rr * 64 + cc * 2; return st * 1024 + (ob ^ (((ob >> 9) & 1) << 5)); }
__host__ __device__ __forceinline__ void stage_rc(int b, int& R, int& C) { const int st = b / 1024, sb = b % 1024, swz = sb ^ (((sb >> 9) & 1) << 5); R = (st >> 1) * 16 + swz / 64; C = (st & 1) * 32 + (swz % 64) / 2; }
__host__ __device__ __forceinline__ int perm32(int rho) { const int n = rho >> 4, i = rho & 15; return 8 * (i >> 2) + 4 * n + (i & 3); }

struct Unit { int pm, pn; };
struct Gemm { const bf16_t* A; const bf16_t* Bt; int M, N, K, lda, ldb; };

struct StaticOrder {
    int nM, nN, nwg, G, c;
    __host__ __device__ void init(int M, int N, int G_, int c_) { nM = M / BM; nN = N / BM; nwg = nM * nN; G = G_; c = c_; }
    __host__ __device__ bool next(int i, Unit& u) const {
        const long L = (long)i * G + c; if (L >= nwg) return false;
        int wgid = (int)L; { const int q = nwg / NXCD, r = nwg % NXCD, xcd = wgid % NXCD, off = wgid / NXCD; wgid = (xcd < r ? xcd * (q + 1) : r * (q + 1) + (xcd - r) * q) + off; }
        const int nig = WGM * nN, gid = wgid / nig, fm = gid * WGM, gsz = (nM - fm) < WGM ? (nM - fm) : WGM;
        u.pm = fm + ((wgid % nig) % gsz); u.pn = (wgid % nig) / gsz; return true;
    }
    __device__ __forceinline__ void a_ready(const Unit&) const {}
    __device__ __forceinline__ void done(const Unit&) const {}
};

__device__ __forceinline__ unsigned cvt_pk_bf16(float lo, float hi) { unsigned r; asm volatile("v_cvt_pk_bf16_f32 %0, %1, %2" : "=v"(r) : "v"(lo), "v"(hi)); return r; }
typedef unsigned u32x2 __attribute__((ext_vector_type(2)));
__device__ __forceinline__ float fast_sigmoid(float x) { return __builtin_amdgcn_rcpf(1.0f + __builtin_amdgcn_exp2f(-1.4426950408889634f * x)); }

struct EpiBf16 {
    static constexpr bool PERM = true, AFTER_DRAIN = false;
    bf16_t* O; int ldc;
    __device__ __forceinline__ void operator()(const f32x4 (&acc)[2][2][4][2], const Unit& u, int wr, int wc, int fr, int fq) const {
        const int row0 = u.pm * BM + wr * 64 + fr; const int col0 = u.pn * BM + wc * 32 + 8 * fq;
#pragma unroll
        for (int ai = 0; ai < 2; ++ai)
#pragma unroll
            for (int m = 0; m < 4; ++m) { bf16_t* rowp = O + (size_t)(row0 + ai * HALF + m * 16) * ldc + col0;
#pragma unroll
                for (int bj = 0; bj < 2; ++bj) { const f32x4 v0 = acc[ai][bj][m][0], v1 = acc[ai][bj][m][1];
                    u32x4 w; w.x = cvt_pk_bf16(v0[0], v0[1]); w.y = cvt_pk_bf16(v0[2], v0[3]); w.z = cvt_pk_bf16(v1[0], v1[1]); w.w = cvt_pk_bf16(v1[2], v1[3]);
                    *(u32x4*)(rowp + bj * HALF) = w; } }
    }
};
typedef _Float16 xh2 __attribute__((ext_vector_type(2))); typedef float xf2 __attribute__((ext_vector_type(2)));
__device__ __forceinline__ unsigned xpk(float lo, float hi) { const xf2 v = {lo, hi}; const xh2 h = __builtin_convertvector(v, xh2); return __builtin_bit_cast(unsigned, h); }
__device__ __forceinline__ float xlo(unsigned w) { const xh2 h = __builtin_bit_cast(xh2, w); return (float)h.x; }
__device__ __forceinline__ float xhi(unsigned w) { const xh2 h = __builtin_bit_cast(xh2, w); return (float)h.y; }
__device__ __forceinline__ float bflo(unsigned w) { return __uint_as_float(w << 16); }
__device__ __forceinline__ float bfhi(unsigned w) { return __uint_as_float(w & 0xffff0000u); }
typedef unsigned ssq_t;
constexpr float SSQ_SCALE = 1024.0f;
__device__ __forceinline__ float ss_get(const ssq_t* ss, int row) { return (float)ss[row] * (1.0f / SSQ_SCALE); }
__device__ __forceinline__ ssq_t ss_fix(float v) { return __float2uint_rn(v * SSQ_SCALE); }
struct RowScale { const ssq_t* ss; const float* dir; float invd, eps;
    __device__ __forceinline__ float operator()(int row) const { return dir ? dir[row] : __builtin_amdgcn_rsqf(ss_get(ss, row) * invd + eps); } };
__device__ __forceinline__ void ss_add(ssq_t* ss, int row, float v, int fq) { v += __shfl_xor(v, 16); v += __shfl_xor(v, 32); if (fq == 0) atomicAdd(ss + row, ss_fix(v)); }

struct EpiBf16Scale {
    static constexpr bool PERM = true, AFTER_DRAIN = false;
    bf16_t* O; int ldc; RowScale rs;
    __device__ __forceinline__ void operator()(const f32x4 (&acc)[2][2][4][2], const Unit& u, int wr, int wc, int fr, int fq) const {
        const int row0 = u.pm * BM + wr * 64 + fr; const int col0 = u.pn * BM + wc * 32 + 8 * fq;
        float rsc[2][4];
#pragma unroll
        for (int ai = 0; ai < 2; ++ai)
#pragma unroll
            for (int m = 0; m < 4; ++m) rsc[ai][m] = rs(row0 + ai * HALF + m * 16);
#pragma unroll
        for (int ai = 0; ai < 2; ++ai)
#pragma unroll
            for (int m = 0; m < 4; ++m) { const int row = row0 + ai * HALF + m * 16; const float r = rsc[ai][m]; bf16_t* rowp = O + (size_t)row * ldc + col0;
#pragma unroll
                for (int bj = 0; bj < 2; ++bj) { const f32x4 v0 = acc[ai][bj][m][0] * r, v1 = acc[ai][bj][m][1] * r;
                    u32x4 w; w.x = cvt_pk_bf16(v0[0], v0[1]); w.y = cvt_pk_bf16(v0[2], v0[3]); w.z = cvt_pk_bf16(v1[0], v1[1]); w.w = cvt_pk_bf16(v1[2], v1[3]);
                    *(u32x4*)(rowp + bj * HALF) = w; } }
    }
};
template <bool BASE_F32, bool OUT_F32> struct EpiRes {
    static constexpr bool PERM = true, AFTER_DRAIN = false;
    const void* base; int ldb; void* out; int ldo; ssq_t* ss;
    bf16_t* slab;
    bf16_t* bcopy;
    __device__ __forceinline__ void operator()(const f32x4 (&acc)[2][2][4][2], const Unit& u, int wr, int wc, int fr, int fq) const {
        int row0 = u.pm * BM + wr * 64 + fr; int col0 = u.pn * BM + wc * 32 + 8 * fq;
        asm volatile("" : "+v"(row0), "+v"(col0));
#pragma unroll
        for (int ai = 0; ai < 2; ++ai) {
            f32x4 b[4][2][2];
#pragma unroll
            for (int m = 0; m < 4; ++m) { const int row = row0 + ai * HALF + m * 16;
#pragma unroll
                for (int bj = 0; bj < 2; ++bj) {
                    if (BASE_F32) { const float* p = (const float*)base + (size_t)row * ldb + col0 + bj * HALF; b[m][bj][0] = *(const f32x4*)p; b[m][bj][1] = *(const f32x4*)(p + 4); }
                    else { const u32x4 w = *(const u32x4*)((const bf16_t*)base + (size_t)row * ldb + col0 + bj * HALF);
                        b[m][bj][0] = (f32x4){xlo(w.x), xhi(w.x), xlo(w.y), xhi(w.y)}; b[m][bj][1] = (f32x4){xlo(w.z), xhi(w.z), xlo(w.w), xhi(w.w)}; } } }
            asm volatile("" ::: "memory");
#pragma unroll
            for (int m = 0; m < 4; ++m) { const int row = row0 + ai * HALF + m * 16; float sq = 0.f;
#pragma unroll
                for (int bj = 0; bj < 2; ++bj) { const f32x4 v0 = b[m][bj][0] + acc[ai][bj][m][0], v1 = b[m][bj][1] + acc[ai][bj][m][1];
                    if (OUT_F32) { float* p = (float*)out + (size_t)row * ldo + col0 + bj * HALF; *(f32x4*)p = v0; *(f32x4*)(p + 4) = v1;
                        sq += (v0[0] * v0[0] + v0[1] * v0[1]) + (v0[2] * v0[2] + v0[3] * v0[3]) + (v1[0] * v1[0] + v1[1] * v1[1]) + (v1[2] * v1[2] + v1[3] * v1[3]); }
                    else { u32x4 w; w.x = xpk(v0[0], v0[1]); w.y = xpk(v0[2], v0[3]); w.z = xpk(v1[0], v1[1]); w.w = xpk(v1[2], v1[3]);
                        *(u32x4*)((bf16_t*)out + (size_t)row * ldo + col0 + bj * HALF) = w;
                        if (bcopy) { u32x4 wb; wb.x = cvt_pk_bf16(v0[0], v0[1]); wb.y = cvt_pk_bf16(v0[2], v0[3]); wb.z = cvt_pk_bf16(v1[0], v1[1]); wb.w = cvt_pk_bf16(v1[2], v1[3]); *(u32x4*)(bcopy + (size_t)row * ldo + col0 + bj * HALF) = wb; }
                        if (slab) { const int col = col0 + bj * HALF; *(u32x4*)(slab + ((size_t)(((row >> 12) * 256 + (col >> 4)) * 4096 + (row & 4095))) * 16 + (col & 8)) = w; }
                        const float a0 = xlo(w.x), a1 = xhi(w.x), a2 = xlo(w.y), a3 = xhi(w.y), a4 = xlo(w.z), a5 = xhi(w.z), a6 = xlo(w.w), a7 = xhi(w.w);
                        sq += (a0 * a0 + a1 * a1) + (a2 * a2 + a3 * a3) + (a4 * a4 + a5 * a5) + (a6 * a6 + a7 * a7); } }
                ss_add(ss, row, sq, fq); }
            asm volatile("" ::: "memory");
        }
    }
};
struct EpiGluRes {
    static constexpr bool PERM = true, AFTER_DRAIN = false;
    bf16_t* X; int ldx; ssq_t* ss;
    __device__ __forceinline__ void operator()(const f32x4 (&acc)[2][2][4][2], const Unit& u, int wr, int wc, int fr, int fq) const {
        const int row0 = u.pm * BM + wr * 64 + fr, col0 = u.pn * HALF + wc * 32 + 8 * fq;
        u32x4 b[2][4];
#pragma unroll
        for (int ai = 0; ai < 2; ++ai)
#pragma unroll
            for (int m = 0; m < 4; ++m) b[ai][m] = *(const u32x4*)(X + (size_t)(row0 + ai * HALF + m * 16) * ldx + col0);
        asm volatile("" ::: "memory");
#pragma unroll
        for (int ai = 0; ai < 2; ++ai)
#pragma unroll
            for (int m = 0; m < 4; ++m) { const int row = row0 + ai * HALF + m * 16; const u32x4 w0 = b[ai][m];
                const f32x4 a0 = acc[ai][0][m][0], g0 = acc[ai][1][m][0], a1 = acc[ai][0][m][1], g1 = acc[ai][1][m][1];
                const float o0 = xlo(w0.x) + a0[0] * fast_sigmoid(g0[0]), o1 = xhi(w0.x) + a0[1] * fast_sigmoid(g0[1]), o2 = xlo(w0.y) + a0[2] * fast_sigmoid(g0[2]), o3 = xhi(w0.y) + a0[3] * fast_sigmoid(g0[3]);
                const float o4 = xlo(w0.z) + a1[0] * fast_sigmoid(g1[0]), o5 = xhi(w0.z) + a1[1] * fast_sigmoid(g1[1]), o6 = xlo(w0.w) + a1[2] * fast_sigmoid(g1[2]), o7 = xhi(w0.w) + a1[3] * fast_sigmoid(g1[3]);
                u32x4 w; w.x = xpk(o0, o1); w.y = xpk(o2, o3); w.z = xpk(o4, o5); w.w = xpk(o6, o7);
                *(u32x4*)(X + (size_t)row * ldx + col0) = w;
                const float q0 = xlo(w.x), q1 = xhi(w.x), q2 = xlo(w.y), q3 = xhi(w.y), q4 = xlo(w.z), q5 = xhi(w.z), q6 = xlo(w.w), q7 = xhi(w.w);
                ss_add(ss, row, (q0 * q0 + q1 * q1) + (q2 * q2 + q3 * q3) + (q4 * q4 + q5 * q5) + (q6 * q6 + q7 * q7), fq); }
    }
};
struct EpiConvGate {
    static constexpr bool PERM = true, AFTER_DRAIN = false;
    bf16_t* ACT; int ldc;
    float* HEAD; float* TAIL;
    const float* cw; const float* cb; int FF, NUP;
    RowScale rs;
    PG8_LAS float* tl;
    const float* wsc;
    __device__ __forceinline__ void operator()(const f32x4 (&acc)[2][2][4][2], const Unit& u, int wr, int wc, int fr, int fq) const {
        asm volatile("" : "+v"(fr), "+v"(fq));
        float rsc[2][4];
#pragma unroll
        for (int ai = 0; ai < 2; ++ai)
#pragma unroll
            for (int m = 0; m < 4; ++m) rsc[ai][m] = rs(u.pm * BM + ai * HALF + wr * 64 + m * 16 + fr);
        const int lcol = wc * 32 + 8 * fq;
        if (fr >= 14) {
#pragma unroll
            for (int ai = 0; ai < 2; ++ai)
#pragma unroll
                for (int bj = 0; bj < 2; ++bj)
#pragma unroll
                    for (int n = 0; n < 2; ++n) *(PG8_LAS f32x4*)(tl + ((2 * ai + wr) * 2 + (fr - 14)) * 256 + bj * HALF + lcol + 4 * n) = acc[ai][bj][3][n] * rsc[ai][3];
        }
        asm volatile("s_waitcnt lgkmcnt(0)" ::: "memory"); __builtin_amdgcn_s_barrier(); asm volatile("" ::: "memory");
#pragma unroll
        for (int n = 0; n < 2; ++n) {
            const int f0 = u.pn * HALF + lcol + 4 * n;
            const int nn = u.pn * BM + lcol + 4 * n;
            f32x4 w0[2], w1[2], w2[2], bb[2];
#pragma unroll
            for (int bj = 0; bj < 2; ++bj) { const float* p = cw + bj * FF + f0; w0[bj] = *(const f32x4*)p; w1[bj] = *(const f32x4*)(p + NUP); w2[bj] = *(const f32x4*)(p + 2 * NUP); bb[bj] = *(const f32x4*)(cb + bj * FF + f0); }
            if (wsc) {
#pragma unroll
                for (int bj = 0; bj < 2; ++bj) { const f32x4 sc = *(const f32x4*)(wsc + nn + bj * HALF); w0[bj] = w0[bj] * sc; w1[bj] = w1[bj] * sc; w2[bj] = w2[bj] * sc; } }
#pragma unroll
            for (int ai = 0; ai < 2; ++ai) {
                const int blkl = 2 * ai + wr;
                if (blkl == 0 && fr < 2) { float* hp = HEAD + (unsigned)((u.pm * 2 + fr) * NUP + nn); *(f32x4*)hp = acc[0][0][0][n] * rsc[0][0]; *(f32x4*)(hp + HALF) = acc[0][1][0][n] * rsc[0][0]; }
                if (blkl == 3 && fr >= 14) { float* tp = TAIL + (unsigned)((u.pm * 2 + (fr - 14)) * NUP + nn); *(f32x4*)tp = acc[1][0][3][n] * rsc[1][3]; *(f32x4*)(tp + HALF) = acc[1][1][3][n] * rsc[1][3]; }
                f32x4 tlv[2];
#pragma unroll
                for (int bj = 0; bj < 2; ++bj) tlv[bj] = *(const PG8_LAS f32x4*)(tl + ((blkl > 0 ? blkl - 1 : 0) * 2 + (fr & 1)) * 256 + bj * HALF + lcol + 4 * n);
#pragma unroll
                for (int m = 0; m < 4; ++m) {
                    f32x4 c[2];
#pragma unroll
                    for (int bj = 0; bj < 2; ++bj) {
                        const f32x4 cur = acc[ai][bj][m][n] * rsc[ai][m], prv = m > 0 ? acc[ai][bj][m > 0 ? m - 1 : 0][n] * rsc[ai][m > 0 ? m - 1 : 0] : tlv[bj];
                        f32x4 u1, u2;
#pragma unroll
                        for (int j = 0; j < 4; ++j) {
                            const float cf = cur[j], pf = prv[j]; const int ci = __float_as_int(cf), pi = __float_as_int(pf);
                            const int p1 = __builtin_amdgcn_update_dpp(0, pi, 0x10F, 0xf, 0xf, true);
                            const int p2 = __builtin_amdgcn_update_dpp(0, pi, 0x10E, 0xf, 0xf, true);
                            u1[j] = __int_as_float(__builtin_amdgcn_update_dpp(p1, ci, 0x111, 0xf, 0xf, false));
                            u2[j] = __int_as_float(__builtin_amdgcn_update_dpp(p2, ci, 0x112, 0xf, 0xf, false));
                        }
                        c[bj] = bb[bj] + w0[bj] * u2 + w1[bj] * u1 + w2[bj] * cur;
                    }
                    f32x4 o;
#pragma unroll
                    for (int j = 0; j < 4; ++j) o[j] = c[0][j] * fast_sigmoid(c[0][j]) * c[1][j];
                    u32x2 w; w.x = cvt_pk_bf16(o[0], o[1]); w.y = cvt_pk_bf16(o[2], o[3]);
                    *(u32x2*)(ACT + (size_t)(u.pm * BM + ai * HALF + wr * 64 + m * 16 + fr) * ldc + f0) = w;
                }
            }
        }
    }
};

typedef _Float16 f16x8 __attribute__((ext_vector_type(8)));
template <bool F16> __device__ __forceinline__ f32x4 mma16(const bf16x8 b, const bf16x8 a, const f32x4 c) {
    if constexpr (F16) return __builtin_amdgcn_mfma_f32_16x16x32_f16(__builtin_bit_cast(f16x8, b), __builtin_bit_cast(f16x8, a), c, 0, 0, 0);
    else return __builtin_amdgcn_mfma_f32_16x16x32_bf16(b, a, c, 0, 0, 0);
}
template <class Epi, class Sched, bool ALIGN_EPI = false, bool SP2 = false, bool F16 = false>
__device__ __forceinline__ void gemm_phase(PG8_LAS unsigned char* lds, const Gemm g, const Sched& S, const Epi& E, const int tz = 0) {
    const int tid = threadIdx.x + tz, wid = __builtin_amdgcn_readfirstlane(tid >> 6), lane = tid & 63, wr = wid >> 2, wc = wid & 3, fr = lane & 15, fq = lane >> 4;
    const int K = g.K, nt = K / BK;
    unsigned voffA[2], voffB[2];
#pragma unroll
    for (int i = 0; i < 2; ++i) { int R, C; stage_rc(tid * 16 + i * 8192, R, C); const int Rb = Epi::PERM ? ((R & ~31) + perm32(R & 31)) : R;
        voffA[i] = (unsigned)(R * g.lda + C) * 2u; voffB[i] = (unsigned)(Rb * g.ldb + C) * 2u; }
    const size_t kstep = (size_t)(BK * 2);
    const size_t hstepA = (size_t)HALF * g.lda * 2, hstepB = (size_t)HALF * g.ldb * 2;
    const size_t tstepA = 2 * hstepA, tstepB = 2 * hstepB;
    const unsigned ldsw = (unsigned)wid * 1024u;
    const int aoff = lds_byte(wr * 64 + fr, fq * 8), boff = lds_byte(wc * 32 + fr, fq * 8);
#define PG8_SA(b, h) (((b) * 2 + (h)) * HTB)
#define PG8_SB(b, h) ((4 + (b) * 2 + (h)) * HTB)
#define PG8_STAGE(bufoff, gbase, voff) do { _Pragma("unroll") for (int _i = 0; _i < 2; ++_i) \
        __builtin_amdgcn_global_load_lds((const unsigned*)((const char*)(gbase) + (voff)[_i]), (PG8_LAS unsigned*)(lds + (bufoff) + ldsw + _i * 8192), 16, 0, 0); } while (0)
#define PG8_LDA(dst, b, h) do { _Pragma("unroll") for (int m = 0; m < 4; ++m) _Pragma("unroll") for (int k = 0; k < 2; ++k) dst[m][k] = *(const PG8_LAS bf16x8*)(lds + PG8_SA(b, h) + aoff + m * 2048 + k * 1024); } while (0)
#define PG8_LDB(dst, b, h) do { _Pragma("unroll") for (int n = 0; n < 2; ++n) _Pragma("unroll") for (int k = 0; k < 2; ++k) dst[n][k] = *(const PG8_LAS bf16x8*)(lds + PG8_SB(b, h) + boff + n * 2048 + k * 1024); } while (0)
#define PG8_MMA(ai, bj, At, Bt) do { __builtin_amdgcn_s_setprio(1); _Pragma("unroll") for (int m = 0; m < 4; ++m) _Pragma("unroll") for (int n = 0; n < 2; ++n) _Pragma("unroll") for (int k = 0; k < 2; ++k) \
        acc[ai][bj][m][n] = mma16<F16>(Bt[n][k], At[m][k], acc[ai][bj][m][n]); __builtin_amdgcn_s_setprio(0); } while (0)
#define PG8_WAIT_V(n) asm volatile("s_waitcnt vmcnt(" #n ")" ::: "memory")
#define PG8_WAIT_L(n) asm volatile("s_waitcnt lgkmcnt(" #n ")" ::: "memory")
#define PG8_BAR __builtin_amdgcn_s_barrier()
#define PG8_SCHED __builtin_amdgcn_sched_barrier(0)
    Unit cur, nxt; int ui = 0;
    if (!S.next(0, cur)) return;
    f32x4 acc[2][2][4][2];
#pragma unroll
    for (int a = 0; a < 2; ++a)
#pragma unroll
        for (int b = 0; b < 2; ++b)
#pragma unroll
            for (int m = 0; m < 4; ++m)
#pragma unroll
                for (int n = 0; n < 2; ++n) acc[a][b][m][n] = (f32x4){0.f, 0.f, 0.f, 0.f};
    bf16x8 At[4][2], B0[2][2], B1[2][2];
    const char* cA = (const char*)g.A + (size_t)cur.pm * tstepA; const char* cB = (const char*)g.Bt + (size_t)cur.pn * tstepB;
    S.a_ready(cur);
    if constexpr (SP2) {
        PG8_STAGE(PG8_SB(0, 0), cB, voffB); PG8_STAGE(PG8_SB(0, 1), cB + hstepB, voffB); PG8_STAGE(PG8_SA(0, 0), cA, voffA); PG8_STAGE(PG8_SA(0, 1), cA + hstepA, voffA);
        if (wr == 1) PG8_BAR;
        PG8_WAIT_V(2); PG8_BAR;
        PG8_STAGE(PG8_SB(1, 0), cB + kstep, voffB); PG8_STAGE(PG8_SA(1, 0), cA + kstep, voffA); PG8_STAGE(PG8_SB(1, 1), cB + hstepB + kstep, voffB);
        PG8_WAIT_V(6); PG8_BAR;
    } else {
        PG8_STAGE(PG8_SB(0, 0), cB, voffB); PG8_STAGE(PG8_SA(0, 0), cA, voffA); PG8_STAGE(PG8_SB(0, 1), cB + hstepB, voffB); PG8_STAGE(PG8_SA(0, 1), cA + hstepA, voffA);
        if (wr == 1) PG8_BAR;
        PG8_WAIT_V(4); PG8_BAR;
        PG8_STAGE(PG8_SB(1, 0), cB + kstep, voffB); PG8_STAGE(PG8_SA(1, 0), cA + kstep, voffA); PG8_STAGE(PG8_SB(1, 1), cB + hstepB + kstep, voffB);
        PG8_WAIT_V(6); PG8_BAR;
    }
    for (;;) {
        const bool has_next = S.next(ui + 1, nxt);
        const char* nA = has_next ? (const char*)g.A + (size_t)nxt.pm * tstepA : cA; const char* nB = has_next ? (const char*)g.Bt + (size_t)nxt.pn * tstepB : cB;
        for (int t = 0; t < nt; t += 2) {
            const bool last = (t == nt - 2);
            const char* a1 = cA + (size_t)(t + 1) * kstep;
            const char* a2 = last ? nA : cA + (size_t)(t + 2) * kstep; const char* b2 = last ? nB : cB + (size_t)(t + 2) * kstep;
            const char* a3 = a2 + kstep; const char* b3 = b2 + kstep;
            if (last && has_next) S.a_ready(nxt);
            if constexpr (SP2) {
            PG8_LDB(B0, 0, 0); PG8_LDB(B1, 0, 1); PG8_SCHED; PG8_LDA(At, 0, 0); PG8_STAGE(PG8_SA(1, 1), a1 + hstepA, voffA);
            PG8_WAIT_V(8); PG8_WAIT_L(0); PG8_BAR; PG8_MMA(0, 0, At, B0); PG8_MMA(0, 1, At, B1); PG8_BAR; PG8_SCHED;
            PG8_LDA(At, 0, 1); PG8_STAGE(PG8_SB(0, 0), b2, voffB); PG8_STAGE(PG8_SB(0, 1), b2 + hstepB, voffB); PG8_STAGE(PG8_SA(0, 0), a2, voffA);
            PG8_WAIT_V(8); PG8_WAIT_L(0); PG8_BAR; PG8_MMA(1, 0, At, B0); PG8_MMA(1, 1, At, B1); PG8_BAR; PG8_SCHED;
            PG8_LDB(B0, 1, 0); PG8_LDB(B1, 1, 1); PG8_SCHED; PG8_LDA(At, 1, 0); PG8_STAGE(PG8_SA(0, 1), a2 + hstepA, voffA);
            PG8_WAIT_V(8); PG8_WAIT_L(0); PG8_BAR; PG8_MMA(0, 0, At, B0); PG8_MMA(0, 1, At, B1); PG8_BAR; PG8_SCHED;
            PG8_LDA(At, 1, 1); PG8_STAGE(PG8_SB(1, 0), b3, voffB); PG8_STAGE(PG8_SB(1, 1), b3 + hstepB, voffB); PG8_STAGE(PG8_SA(1, 0), a3, voffA);
            PG8_WAIT_V(8); PG8_WAIT_L(0); PG8_BAR; PG8_MMA(1, 0, At, B0); PG8_MMA(1, 1, At, B1); PG8_BAR; PG8_SCHED;
            } else {
            PG8_LDB(B0, 0, 0); PG8_SCHED; PG8_LDA(At, 0, 0); PG8_STAGE(PG8_SA(1, 1), a1 + hstepA, voffA);
            PG8_WAIT_L(8); PG8_BAR; PG8_WAIT_L(0); PG8_MMA(0, 0, At, B0); PG8_BAR; PG8_SCHED;
            PG8_LDB(B1, 0, 1); PG8_STAGE(PG8_SB(0, 0), b2, voffB);
            PG8_BAR; PG8_WAIT_L(0); PG8_MMA(0, 1, At, B1); PG8_BAR;
            PG8_LDA(At, 0, 1); PG8_STAGE(PG8_SA(0, 0), a2, voffA);
            PG8_BAR; PG8_WAIT_L(0); PG8_MMA(1, 0, At, B0); PG8_BAR; PG8_SCHED;
            PG8_STAGE(PG8_SB(0, 1), b2 + hstepB, voffB);
            PG8_WAIT_V(6); PG8_BAR; PG8_MMA(1, 1, At, B1); PG8_BAR;
            PG8_LDB(B0, 1, 0); PG8_SCHED; PG8_LDA(At, 1, 0); PG8_STAGE(PG8_SA(0, 1), a2 + hstepA, voffA);
            PG8_WAIT_L(8); PG8_BAR; PG8_WAIT_L(0); PG8_MMA(0, 0, At, B0); PG8_BAR; PG8_SCHED;
            PG8_LDB(B1, 1, 1); PG8_STAGE(PG8_SB(1, 0), b3, voffB);
            PG8_BAR; PG8_WAIT_L(0); PG8_MMA(0, 1, At, B1); PG8_BAR;
            PG8_LDA(At, 1, 1); PG8_STAGE(PG8_SA(1, 0), a3, voffA);
            PG8_BAR; PG8_WAIT_L(0); PG8_MMA(1, 0, At, B0); PG8_BAR; PG8_SCHED;
            PG8_STAGE(PG8_SB(1, 1), b3 + hstepB, voffB);
            PG8_WAIT_V(6); PG8_BAR; PG8_MMA(1, 1, At, B1); PG8_BAR;
            }
        }
        if constexpr (ALIGN_EPI) { if (wr == 0) PG8_BAR; }
        if constexpr (!Epi::AFTER_DRAIN) { E(acc, cur, wr, wc, fr, fq); S.done(cur); }
        if (!has_next) break;
#pragma unroll
        for (int a = 0; a < 2; ++a)
#pragma unroll
            for (int b = 0; b < 2; ++b)
#pragma unroll
                for (int m = 0; m < 4; ++m)
#pragma unroll
                    for (int n = 0; n < 2; ++n) acc[a][b][m][n] = (f32x4){0.f, 0.f, 0.f, 0.f};
        cur = nxt; cA = nA; cB = nB; ++ui;
        if constexpr (ALIGN_EPI) { if (wr == 1) PG8_BAR; }
    }
    PG8_WAIT_V(0);
    if constexpr (!ALIGN_EPI) { if (wr == 0) PG8_BAR; }
    PG8_BAR;
    if constexpr (Epi::AFTER_DRAIN) { E.fused(acc, cur, wr, wc, fr, fq, lds, wid, lane); S.done(cur); }
#undef PG8_SA
#undef PG8_SB
#undef PG8_STAGE
#undef PG8_LDA
#undef PG8_LDB
#undef PG8_MMA
#undef PG8_WAIT_V
#undef PG8_WAIT_L
#undef PG8_BAR
#undef PG8_SCHED
}
template <class Epi, class Sched, bool ALIGN_EPI = false, bool SP2 = false>
__device__ __forceinline__ void gemm_phase_i8(PG8_LAS unsigned char* lds, const Gemm g, const Sched& S, const Epi& E) {
    const int tid = threadIdx.x, wid = __builtin_amdgcn_readfirstlane(tid >> 6), lane = tid & 63, wr = wid >> 2, wc = wid & 3, fr = lane & 15, fq = lane >> 4;
    const int K = g.K, nt = K / BK;
    unsigned voffA[2], voffB[2];
#pragma unroll
    for (int i = 0; i < 2; ++i) { int R, C; stage_rc(tid * 16 + i * 8192, R, C); const int Rb = Epi::PERM ? ((R & ~31) + perm32(R & 31)) : R;
        voffA[i] = (unsigned)(R * g.lda + C) * 2u; voffB[i] = (unsigned)(Rb * g.ldb + C) * 2u; }
    const size_t kstep = (size_t)(BK * 2);
    const size_t hstepA = (size_t)HALF * g.lda * 2, hstepB = (size_t)HALF * g.ldb * 2;
    const size_t tstepA = 2 * hstepA, tstepB = 2 * hstepB;
    const unsigned ldsw = (unsigned)wid * 1024u;
    const int aoff = lds_byte(wr * 64 + fr, fq * 8), boff = lds_byte(wc * 32 + fr, fq * 8);
#define PG8_SA(b, h) (((b) * 2 + (h)) * HTB)
#define PG8_SB(b, h) ((4 + (b) * 2 + (h)) * HTB)
#define PG8_STAGE(bufoff, gbase, voff) do { _Pragma("unroll") for (int _i = 0; _i < 2; ++_i) \
        __builtin_amdgcn_global_load_lds((const unsigned*)((const char*)(gbase) + (voff)[_i]), (PG8_LAS unsigned*)(lds + (bufoff) + ldsw + _i * 8192), 16, 0, 0); } while (0)
#define PG8_LDA(dst, b, h) do { _Pragma("unroll") for (int m = 0; m < 4; ++m) _Pragma("unroll") for (int k = 0; k < 2; ++k) dst[m][k] = *(const PG8_LAS bf16x8*)(lds + PG8_SA(b, h) + aoff + m * 2048 + k * 1024); } while (0)
#define PG8_LDB(dst, b, h) do { _Pragma("unroll") for (int n = 0; n < 2; ++n) _Pragma("unroll") for (int k = 0; k < 2; ++k) dst[n][k] = *(const PG8_LAS bf16x8*)(lds + PG8_SB(b, h) + boff + n * 2048 + k * 1024); } while (0)
#define PG8_MMA(ai, bj, At, Bt) do { __builtin_amdgcn_s_setprio(1); _Pragma("unroll") for (int m = 0; m < 4; ++m) _Pragma("unroll") for (int n = 0; n < 2; ++n) _Pragma("unroll") for (int k = 0; k < 2; ++k) \
        acc[ai][bj][m][n] = __builtin_amdgcn_mfma_i32_16x16x64_i8(__builtin_bit_cast(i32x4, Bt[n][k]), __builtin_bit_cast(i32x4, At[m][k]), acc[ai][bj][m][n], 0, 0, 0); __builtin_amdgcn_s_setprio(0); } while (0)
#define PG8_WAIT_V(n) asm volatile("s_waitcnt vmcnt(" #n ")" ::: "memory")
#define PG8_WAIT_L(n) asm volatile("s_waitcnt lgkmcnt(" #n ")" ::: "memory")
#define PG8_BAR __builtin_amdgcn_s_barrier()
#define PG8_SCHED __builtin_amdgcn_sched_barrier(0)
    Unit cur, nxt; int ui = 0;
    if (!S.next(0, cur)) return;
    i32x4 acc[2][2][4][2];
#pragma unroll
    for (int a = 0; a < 2; ++a)
#pragma unroll
        for (int b = 0; b < 2; ++b)
#pragma unroll
            for (int m = 0; m < 4; ++m)
#pragma unroll
                for (int n = 0; n < 2; ++n) acc[a][b][m][n] = (i32x4){0, 0, 0, 0};
    bf16x8 At[4][2], B0[2][2], B1[2][2];
    const char* cA = (const char*)g.A + (size_t)cur.pm * tstepA; const char* cB = (const char*)g.Bt + (size_t)cur.pn * tstepB;
    S.a_ready(cur);
    if constexpr (SP2) {
        PG8_STAGE(PG8_SB(0, 0), cB, voffB); PG8_STAGE(PG8_SB(0, 1), cB + hstepB, voffB); PG8_STAGE(PG8_SA(0, 0), cA, voffA); PG8_STAGE(PG8_SA(0, 1), cA + hstepA, voffA);
        if (wr == 1) PG8_BAR;
        PG8_WAIT_V(2); PG8_BAR;
        PG8_STAGE(PG8_SB(1, 0), cB + kstep, voffB); PG8_STAGE(PG8_SA(1, 0), cA + kstep, voffA); PG8_STAGE(PG8_SB(1, 1), cB + hstepB + kstep, voffB);
        PG8_WAIT_V(6); PG8_BAR;
    } else {
        PG8_STAGE(PG8_SB(0, 0), cB, voffB); PG8_STAGE(PG8_SA(0, 0), cA, voffA); PG8_STAGE(PG8_SB(0, 1), cB + hstepB, voffB); PG8_STAGE(PG8_SA(0, 1), cA + hstepA, voffA);
        if (wr == 1) PG8_BAR;
        PG8_WAIT_V(4); PG8_BAR;
        PG8_STAGE(PG8_SB(1, 0), cB + kstep, voffB); PG8_STAGE(PG8_SA(1, 0), cA + kstep, voffA); PG8_STAGE(PG8_SB(1, 1), cB + hstepB + kstep, voffB);
        PG8_WAIT_V(6); PG8_BAR;
    }
    for (;;) {
        const bool has_next = S.next(ui + 1, nxt);
        const char* nA = has_next ? (const char*)g.A + (size_t)nxt.pm * tstepA : cA; const char* nB = has_next ? (const char*)g.Bt + (size_t)nxt.pn * tstepB : cB;
        for (int t = 0; t < nt; t += 2) {
            const bool last = (t == nt - 2);
            const char* a1 = cA + (size_t)(t + 1) * kstep;
            const char* a2 = last ? nA : cA + (size_t)(t + 2) * kstep; const char* b2 = last ? nB : cB + (size_t)(t + 2) * kstep;
            const char* a3 = a2 + kstep; const char* b3 = b2 + kstep;
            if (last && has_next) S.a_ready(nxt);
            if constexpr (SP2) {
            PG8_LDB(B0, 0, 0); PG8_LDB(B1, 0, 1); PG8_SCHED; PG8_LDA(At, 0, 0); PG8_STAGE(PG8_SA(1, 1), a1 + hstepA, voffA);
            PG8_WAIT_V(8); PG8_WAIT_L(0); PG8_BAR; PG8_MMA(0, 0, At, B0); PG8_MMA(0, 1, At, B1); PG8_BAR; PG8_SCHED;
            PG8_LDA(At, 0, 1); PG8_STAGE(PG8_SB(0, 0), b2, voffB); PG8_STAGE(PG8_SB(0, 1), b2 + hstepB, voffB); PG8_STAGE(PG8_SA(0, 0), a2, voffA);
            PG8_WAIT_V(8); PG8_WAIT_L(0); PG8_BAR; PG8_MMA(1, 0, At, B0); PG8_MMA(1, 1, At, B1); PG8_BAR; PG8_SCHED;
            PG8_LDB(B0, 1, 0); PG8_LDB(B1, 1, 1); PG8_SCHED; PG8_LDA(At, 1, 0); PG8_STAGE(PG8_SA(0, 1), a2 + hstepA, voffA);
            PG8_WAIT_V(8); PG8_WAIT_L(0); PG8_BAR; PG8_MMA(0, 0, At, B0); PG8_MMA(0, 1, At, B1); PG8_BAR; PG8_SCHED;
            PG8_LDA(At, 1, 1); PG8_STAGE(PG8_SB(1, 0), b3, voffB); PG8_STAGE(PG8_SB(1, 1), b3 + hstepB, voffB); PG8_STAGE(PG8_SA(1, 0), a3, voffA);
            PG8_WAIT_V(8); PG8_WAIT_L(0); PG8_BAR; PG8_MMA(1, 0, At, B0); PG8_MMA(1, 1, At, B1); PG8_BAR; PG8_SCHED;
            } else {
            PG8_LDB(B0, 0, 0); PG8_SCHED; PG8_LDA(At, 0, 0); PG8_STAGE(PG8_SA(1, 1), a1 + hstepA, voffA);
            PG8_WAIT_L(8); PG8_BAR; PG8_WAIT_L(0); PG8_MMA(0, 0, At, B0); PG8_BAR; PG8_SCHED;
            PG8_LDB(B1, 0, 1); PG8_STAGE(PG8_SB(0, 0), b2, voffB);
            PG8_BAR; PG8_WAIT_L(0); PG8_MMA(0, 1, At, B1); PG8_BAR;
            PG8_LDA(At, 0, 1); PG8_STAGE(PG8_SA(0, 0), a2, voffA);
            PG8_BAR; PG8_WAIT_L(0); PG8_MMA(1, 0, At, B0); PG8_BAR; PG8_SCHED;
            PG8_STAGE(PG8_SB(0, 1), b2 + hstepB, voffB);
            PG8_WAIT_V(6); PG8_BAR; PG8_MMA(1, 1, At, B1); PG8_BAR;
            PG8_LDB(B0, 1, 0); PG8_SCHED; PG8_LDA(At, 1, 0); PG8_STAGE(PG8_SA(0, 1), a2 + hstepA, voffA);
            PG8_WAIT_L(8); PG8_BAR; PG8_WAIT_L(0); PG8_MMA(0, 0, At, B0); PG8_BAR; PG8_SCHED;
            PG8_LDB(B1, 1, 1); PG8_STAGE(PG8_SB(1, 0), b3, voffB);
            PG8_BAR; PG8_WAIT_L(0); PG8_MMA(0, 1, At, B1); PG8_BAR;
            PG8_LDA(At, 1, 1); PG8_STAGE(PG8_SA(1, 0), a3, voffA);
            PG8_BAR; PG8_WAIT_L(0); PG8_MMA(1, 0, At, B0); PG8_BAR; PG8_SCHED;
            PG8_STAGE(PG8_SB(1, 1), b3 + hstepB, voffB);
            PG8_WAIT_V(6); PG8_BAR; PG8_MMA(1, 1, At, B1); PG8_BAR;
            }
        }
        if constexpr (ALIGN_EPI) { if (wr == 0) PG8_BAR; }
        if constexpr (!Epi::AFTER_DRAIN) {
            f32x4 accf[2][2][4][2];
#pragma unroll
            for (int a = 0; a < 2; ++a)
#pragma unroll
                for (int b = 0; b < 2; ++b)
#pragma unroll
                    for (int m = 0; m < 4; ++m)
#pragma unroll
                        for (int n = 0; n < 2; ++n) accf[a][b][m][n] = __builtin_convertvector(acc[a][b][m][n], f32x4);
            E(accf, cur, wr, wc, fr, fq); S.done(cur); }
        if (!has_next) break;
#pragma unroll
        for (int a = 0; a < 2; ++a)
#pragma unroll
            for (int b = 0; b < 2; ++b)
#pragma unroll
                for (int m = 0; m < 4; ++m)
#pragma unroll
                    for (int n = 0; n < 2; ++n) acc[a][b][m][n] = (i32x4){0, 0, 0, 0};
        cur = nxt; cA = nA; cB = nB; ++ui;
        if constexpr (ALIGN_EPI) { if (wr == 1) PG8_BAR; }
    }
    PG8_WAIT_V(0);
    if constexpr (!ALIGN_EPI) { if (wr == 0) PG8_BAR; }
    PG8_BAR;
#undef PG8_SA
#undef PG8_SB
#undef PG8_STAGE
#undef PG8_LDA
#undef PG8_LDB
#undef PG8_MMA
#undef PG8_WAIT_V
#undef PG8_WAIT_L
#undef PG8_BAR
#undef PG8_SCHED
}
}
#define GAS __attribute__((address_space(1)))
#define LAS __attribute__((address_space(3)))
typedef unsigned short bf16;
typedef unsigned v4u __attribute__((ext_vector_type(4)));
typedef float f32x4 __attribute__((ext_vector_type(4)));
typedef short bf16x8 __attribute__((ext_vector_type(8)));
typedef GAS unsigned gu32;
typedef GAS unsigned long long gu64;
#define RLX_AGENT __ATOMIC_RELAXED, __HIP_MEMORY_SCOPE_AGENT
#define LDS_WAIT() asm volatile("s_waitcnt lgkmcnt(0)" ::: "memory")
#define VM_WAIT() asm volatile("s_waitcnt vmcnt(0)" ::: "memory")
__device__ __forceinline__ unsigned long long rt() { return __builtin_amdgcn_s_memrealtime(); }
__device__ __forceinline__ unsigned f2bf(float f) { unsigned u = __builtin_bit_cast(unsigned, f); return (u + 0x7fffu + ((u >> 16) & 1u)) >> 16; }
typedef __bf16 hw_bf16x2 __attribute__((ext_vector_type(2))); typedef float hw_f32x2 __attribute__((ext_vector_type(2)));
__device__ __forceinline__ unsigned pk2(float lo, float hi) { const hw_f32x2 v = {lo, hi}; return __builtin_bit_cast(unsigned, __builtin_convertvector(v, hw_bf16x2)); }

#define XB_TMO      128
#define XB_XCNT(j)  (256  + 64 * (j))
#define XB_XSUB(j)  (1280 + 64 * (j))
#define XB_XGEN(j)  (2304 + 64 * (j))
#define XB_TOP      3328
#define XB_TOPGEN   3392
#define XCD_BAR_WORDS 3456
#define XB_SPIN_CAP (1u << 18)

__device__ __forceinline__ unsigned xb_ld(unsigned* p)              { return __hip_atomic_load(p, __ATOMIC_RELAXED, __HIP_MEMORY_SCOPE_AGENT); }
__device__ __forceinline__ unsigned xb_add(unsigned* p, unsigned v) { return __hip_atomic_fetch_add(p, v, __ATOMIC_RELAXED, __HIP_MEMORY_SCOPE_AGENT); }
__device__ __forceinline__ unsigned xb_xcc_id() { return (unsigned)__builtin_amdgcn_s_getreg((3 << 11) | 20) & 0xFu; }
#define XB_SPIN(cond, bar) do { unsigned _sp = 0; while (cond) { __builtin_amdgcn_s_sleep(1); \
    if ((++_sp & 255u) == 0u) { if (xb_ld(&(bar)[XB_TMO])) break; if (_sp > XB_SPIN_CAP) { atomicAdd(&(bar)[XB_TMO], 1u); break; } } } } while (0)

struct XcdBarrier {
    unsigned* bar; unsigned x;
    volatile LAS unsigned* st;
};

__device__ __forceinline__ XcdBarrier xcd_barrier_post(unsigned* bar, volatile LAS unsigned* st) {
    XcdBarrier b; b.bar = bar; b.x = xb_xcc_id(); b.st = st;
    if (threadIdx.x == 0) (void)xb_add(&bar[XB_XCNT(b.x)], 1u);
    return b;
}
__device__ __forceinline__ void xcd_barrier_complete(unsigned* bar, unsigned x, unsigned& nloc, unsigned& nx) {
    const unsigned G = gridDim.x * gridDim.y * gridDim.z;
    unsigned sum, cnt, mine, sp = 0u;
    for (;;) {
        sum = 0u; cnt = 0u; mine = 0u;
#pragma unroll
        for (unsigned j = 0; j < 16; ++j) { const unsigned c = xb_ld(&bar[XB_XCNT(j)]); sum += c; cnt += (c > 0u) ? 1u : 0u; mine = (j == x) ? c : mine; }
        if (sum == G) break;
        __builtin_amdgcn_s_sleep(1);
        if ((++sp & 255u) == 0u) { if (xb_ld(&bar[XB_TMO])) break; if (sp > XB_SPIN_CAP) { atomicAdd(&bar[XB_TMO], 1u); break; } }
    }
    nloc = mine > 0u ? mine : 1u; nx = cnt > 0u ? cnt : 1u;
}

__device__ __forceinline__ void xcd_barrier(const XcdBarrier& b) {
    asm volatile("s_waitcnt vmcnt(0)" ::: "memory");
    __syncthreads();
    if (threadIdx.x == 0) {
        unsigned* bar = b.bar;
        __builtin_amdgcn_s_waitcnt(0);
        unsigned nloc = b.st[0], nx = b.st[1];
        if (nloc == 0u) { xcd_barrier_complete(bar, b.x, nloc, nx); b.st[0] = nloc; b.st[1] = nx; }
        const unsigned old = xb_add(&bar[XB_XSUB(b.x)], 1u);
        const unsigned gen = old / nloc;
        if (old + 1u == (gen + 1u) * nloc) {
            __builtin_amdgcn_fence(__ATOMIC_RELEASE, "agent");
            asm volatile("s_waitcnt vmcnt(0)" ::: "memory");
            const unsigned og = xb_add(&bar[XB_TOP], 1u);
            const unsigned tg = og / nx;
            if (og + 1u == (tg + 1u) * nx) xb_add(&bar[XB_TOPGEN], 1u);
            else XB_SPIN(xb_ld(&bar[XB_TOPGEN]) == tg, bar);
            __builtin_amdgcn_fence(__ATOMIC_ACQUIRE, "agent");
            xb_add(&bar[XB_XGEN(b.x)], 1u);
            asm volatile("s_waitcnt vmcnt(0)" ::: "memory");
        } else {
            XB_SPIN(xb_ld(&bar[XB_XGEN(b.x)]) == gen, bar);
            __builtin_amdgcn_fence(__ATOMIC_ACQUIRE, "agent");
            asm volatile("s_waitcnt vmcnt(0)" ::: "memory");
        }
    }
    __syncthreads();
}

constexpr int NWAVES = 8;
constexpr int BATCH = 2, SEQ = 4096, DM = 4096, M = BATCH * SEQ;
constexpr int NH = 64, NKV = 8, HD = 64, QKVW = 5120;
constexpr int FF = 11008, NUP = 2 * FF;
constexpr int SG = 256, SGC = 16, SP = 64;
constexpr float EPS = 1e-6f;
constexpr int LDX = DM + 128, LDACT = FF + 128;
constexpr int LDW = DM + 128, LDWF = FF + 128;
#ifndef MK_N_LAUNCHES
#define MK_N_LAUNCHES 1
#endif
constexpr int N_PHASES = 13;
constexpr int N_LAUNCHES = MK_N_LAUNCHES;

constexpr size_t MiB = 1u << 20;
constexpr size_t WS_CTL = 0, CTL_ZERO_BYTES = 1 * MiB;
constexpr size_t WS_WQKV = 2 * MiB;
constexpr size_t WS_WO   = WS_WQKV + 42 * MiB;
constexpr size_t WS_WUP0 = WS_WO + 34 * MiB;
constexpr size_t WS_WUP1 = WS_WUP0 + 178 * MiB;
constexpr size_t WS_WDN0 = WS_WUP1 + 178 * MiB;
constexpr size_t WS_WDN1 = WS_WDN0 + 88 * MiB;
constexpr size_t WS_WGLU = WS_WDN1 + 88 * MiB;
constexpr size_t WS_X    = WS_WGLU + 67 * MiB;
constexpr size_t WS_XN   = WS_X + 128 * MiB;
constexpr size_t WS_QKV  = WS_XN + 67 * MiB;
constexpr size_t WS_AO   = WS_QKV + 80 * MiB;
constexpr size_t WS_ACT  = WS_AO + 67 * MiB;
constexpr size_t WS_HEAD = WS_ACT + 175 * MiB;
constexpr size_t WS_TAIL = WS_HEAD + 22 * MiB;
constexpr size_t WS_S5KT = WS_TAIL + 22 * MiB;
constexpr size_t WS_S5BE = WS_S5KT + 5 * MiB;
constexpr size_t WS_S5CP = WS_S5BE + 32 * MiB;
constexpr size_t WS_S5AT = WS_S5CP + 32 * MiB;
constexpr size_t WS_S5H  = WS_S5AT + 1 * MiB;
#ifndef UP0_I8_TILES
#define UP0_I8_TILES 48
#endif
constexpr int NI8 = UP0_I8_TILES * 256;
constexpr int LDQ = DM + 256;
constexpr size_t WS_XQ   = WS_S5H + 64 * MiB;
constexpr size_t WS_WQ1  = WS_XQ + 36 * MiB;
constexpr size_t WS_ASC  = WS_WQ1 + 92 * MiB;
constexpr size_t WS_WSC1 = WS_ASC + 1 * MiB;
constexpr size_t WS_WQ0  = WS_WSC1 + 1 * MiB;
constexpr size_t WS_WSC0 = WS_WQ0 + 92 * MiB;
constexpr size_t WS_XNB  = WS_WSC0 + 1 * MiB;
constexpr size_t WS_END  = WS_XNB + 67 * MiB;
static_assert((size_t)M * LDQ <= 36 * MiB && (size_t)NUP * LDQ <= 92 * MiB, "int8 ws map");
constexpr size_t WS_SS = 262144;
static_assert((size_t)QKVW * LDW * 2 <= 42 * MiB && (size_t)DM * LDW * 2 <= 34 * MiB && (size_t)NUP * LDW * 2 <= 178 * MiB && (size_t)DM * LDWF * 2 <= 88 * MiB && (size_t)2 * DM * LDW * 2 <= 67 * MiB && (size_t)M * LDX * 2 <= 67 * MiB && (size_t)M * LDACT * 2 <= 175 * MiB && (size_t)(M / 64) * 2 * NUP * 4 <= 22 * MiB, "ws map");
constexpr int CW_BAR = 4096;

constexpr int RING_OFF = 0, RING_BYTES = 131072;
constexpr int LDSCTL_OFF = RING_BYTES, MISC_OFF = LDSCTL_OFF + 320;
constexpr int LDS_BYTES = 147456;
static_assert(MISC_OFF + 128 <= LDS_BYTES, "LDS map");

typedef unsigned v2u __attribute__((ext_vector_type(2)));
using pg8::ssq_t; using pg8::ss_get; using pg8::ss_fix; using pg8::xpk; using pg8::xlo; using pg8::xhi;
struct Frame {
    LAS unsigned char* lds;
    volatile LAS unsigned* MISC;
    gu32* ctl;
    int tid, lane, wave;
    int vcu, G;
};
__device__ __forceinline__ float wave_sum(float v) {
#pragma unroll
    for (int o = 1; o < 64; o <<= 1) v += __shfl_xor(v, o);
    return v;
}
__device__ __forceinline__ float bf_lo(unsigned w) { return __uint_as_float(w << 16); }
__device__ __forceinline__ float bf_hi(unsigned w) { return __uint_as_float(w & 0xffff0000u); }

__device__ __forceinline__ int rowmap(int n, int Hh) { if (Hh == 0) return n; const int half = n >= Hh ? 1 : 0; const int f = n - half * Hh; return ((f >> 7) << 8) + (half << 7) + (f & 127); }
struct CvtJob { const float* W; bf16* WT; const float* gain; int N, ldw, Hh, k0, n0, kgl, h16; };
constexpr int CI_QKV = (DM / 64) * (QKVW / 32), CI_O = (DM / 64) * (DM / 32), CI_UP = (DM / 64) * (NUP / 32), CI_DN = (FF / 64) * (DM / 32), CI_GLU = (DM / 64) * (2 * DM / 32);
constexpr int CI_UP0 = (DM / 64) * ((NUP - NI8) / 32);
static_assert(((NUP - NI8) / 32) % 16 == 0 && (NI8 / 2) % 32 == 0, "bf16 part of the layer-0 up weights: whole super-blocks");
constexpr int CVT_ITEMS = CI_QKV + CI_O + CI_UP0 + 2 * CI_DN + CI_GLU;
#ifndef CVT_Q1
#define CVT_Q1 12
#endif
#ifndef CVT_Q2
#define CVT_Q2 14
#endif
constexpr int CVT_W1 = 128 * NWAVES, CVT_W2 = 64 * NWAVES;
constexpr int CVT_N1 = CVT_W1 * CVT_Q1, CVT_N2 = CVT_W2 * CVT_Q2, CVT_NP = CVT_ITEMS - CVT_N1 - CVT_N2;
static_assert(CVT_NP >= CI_QKV + CI_O + CI_UP0 + CI_DN, "the prologue must convert everything layer 0 needs");
__device__ __forceinline__ CvtJob cvt_job(int it, const float* const* in, unsigned char* ws) {
    CvtJob j; int r = it; j.gain = nullptr; bool up0 = false;
    j.h16 = 0;
    if (r < CI_QKV) { j.W = in[2]; j.WT = (bf16*)(ws + WS_WQKV); j.N = QKVW; j.ldw = LDW; j.Hh = 0; j.gain = in[1]; j.kgl = 3; }
    else if ((r -= CI_QKV) < CI_O) { j.W = in[3]; j.WT = (bf16*)(ws + WS_WO); j.N = DM; j.ldw = LDW; j.Hh = 0; j.kgl = 3; }
    else if ((r -= CI_O) < CI_UP0) { up0 = true; j.W = in[17]; j.WT = (bf16*)(ws + WS_WUP0); j.N = NUP; j.ldw = LDW; j.Hh = FF; j.gain = in[16]; j.kgl = 4; }
    else if ((r -= CI_UP0) < CI_DN) { j.W = in[20]; j.WT = (bf16*)(ws + WS_WDN0); j.N = DM; j.ldw = LDWF; j.Hh = 0; j.kgl = 2; }
    else if ((r -= CI_DN) < CI_GLU) { j.W = in[15]; j.WT = (bf16*)(ws + WS_WGLU); j.N = 2 * DM; j.ldw = LDW; j.Hh = DM; j.kgl = 3; }
    else { r -= CI_GLU; j.W = in[20] + (size_t)FF * DM; j.WT = (bf16*)(ws + WS_WDN1); j.N = DM; j.ldw = LDWF; j.Hh = 0; j.kgl = 2; }
    const int ngl = 8 - j.kgl, nblk = up0 ? (NUP - NI8) >> 5 : j.N >> 5, ngrp = nblk >> ngl;
    const int sb = r >> 8, wi = r & 255, kgi = sb / ngrp, ngi = sb - kgi * ngrp;
    const int kb = (kgi << j.kgl) + (wi >> ngl), nb = (ngi << ngl) + (wi & ((1 << ngl) - 1));
    j.k0 = 64 * kb; j.n0 = 32 * nb;
    if (up0) j.n0 += (j.n0 < (NUP - NI8) / 2) ? NI8 / 2 : NI8 / 2 + NI8 / 2;
    return j;
}
__device__ __forceinline__ void cvt_load(const CvtJob& j, int lane, f32x4 (&v)[8], float (&gk)[8]) {
    const float* p = j.W + (size_t)(j.k0 + (lane >> 3)) * j.N + j.n0 + 4 * (lane & 7);
#pragma unroll
    for (int i = 0; i < 8; ++i) v[i] = __builtin_nontemporal_load((const GAS f32x4*)(p + (size_t)(8 * i) * j.N));
    const float* gp = (j.gain ? j.gain : j.W) + j.k0 + (lane >> 3);
#pragma unroll
    for (int i = 0; i < 8; ++i) { const float t = gp[8 * i]; gk[i] = j.gain ? t : 1.0f; }
}
__device__ __forceinline__ void cvt_store(const CvtJob& j, int lane, const f32x4 (&v)[8], const float (&gk)[8], LAS float* scr) {
    const int kr = lane >> 3, nq = 4 * (lane & 7);
#pragma unroll
    for (int i = 0; i < 8; ++i) { LAS float* d = scr + (8 * i + kr) * 33 + nq; d[0] = v[i].x * gk[i]; d[1] = v[i].y * gk[i]; d[2] = v[i].z * gk[i]; d[3] = v[i].w * gk[i]; }
    LDS_WAIT(); asm volatile("" ::: "memory");
    const int c = lane & 7; const int r0 = rowmap(j.n0, j.Hh);
#pragma unroll
    for (int jj = 0; jj < 4; ++jj) { const int n = (lane >> 3) + 8 * jj; const LAS float* s = scr + (8 * c) * 33 + n;
        v4u o;
        if (j.h16) { o.x = xpk(s[0 * 33], s[1 * 33]); o.y = xpk(s[2 * 33], s[3 * 33]); o.z = xpk(s[4 * 33], s[5 * 33]); o.w = xpk(s[6 * 33], s[7 * 33]); }
        else { o.x = pk2(s[0 * 33], s[1 * 33]); o.y = pk2(s[2 * 33], s[3 * 33]); o.z = pk2(s[4 * 33], s[5 * 33]); o.w = pk2(s[6 * 33], s[7 * 33]); }
        __builtin_nontemporal_store(o, (GAS v4u*)(j.WT + (size_t)(r0 + n) * j.ldw + j.k0 + 8 * c)); }
    LDS_WAIT(); asm volatile("" ::: "memory");
}
__device__ __forceinline__ void convert_weights(Frame& F, const float* const* in, unsigned char* ws, int first, int count, int rank, int nwaves) {
    LAS float* scr = (LAS float*)(F.lds + RING_OFF + F.wave * 16384);
    const int end = first + count, last = end - 1;
    int it = first + rank; if (it >= end) return;
    CvtJob jA = cvt_job(it, in, ws); f32x4 vA[8]; float gA[8]; cvt_load(jA, F.lane, vA, gA);
    CvtJob jB = cvt_job(min(it + nwaves, last), in, ws); f32x4 vB[8]; float gB[8]; cvt_load(jB, F.lane, vB, gB);
    for (; it < end; it += 2 * nwaves) {
        cvt_store(jA, F.lane, vA, gA, scr);                     asm volatile("" ::: "memory");
        jA = cvt_job(min(it + 2 * nwaves, last), in, ws); cvt_load(jA, F.lane, vA, gA);   asm volatile("" ::: "memory");
        if (it + nwaves < end) cvt_store(jB, F.lane, vB, gB, scr);   asm volatile("" ::: "memory");
        jB = cvt_job(min(it + 3 * nwaves, last), in, ws); cvt_load(jB, F.lane, vB, gB);   asm volatile("" ::: "memory");
    }
}
__device__ __forceinline__ unsigned q4(float a, float b, float c, float e, float inv) {
    const int i0 = __float2int_rn(a * inv), i1 = __float2int_rn(b * inv), i2 = __float2int_rn(c * inv), i3 = __float2int_rn(e * inv);
    return (unsigned)(i0 & 0xff) | ((unsigned)(i1 & 0xff) << 8) | ((unsigned)(i2 & 0xff) << 16) | ((unsigned)(i3 & 0xff) << 24);
}
constexpr int NPAN0 = NI8 / 32, NPAN1 = NUP / 32, NPAN = NPAN0 + NPAN1;
__device__ __forceinline__ void convert_panels(Frame& F, const float* const* in, unsigned char* ws, int first, int count, int rank, int nwg) {
    LAS unsigned char* pan = F.lds + RING_OFF;
    LAS unsigned* cmax = (LAS unsigned*)(F.lds + LDSCTL_OFF + 1024);
    const int t = F.tid, c8 = t & 7, r = t >> 3;
    const int end = first + count;
#define PAN_R0(p_) (32 * ((p_) >= NPAN0 ? (p_) - NPAN0 : (p_)))
#define PAN_SRC(p_) (in[17] + ((p_) >= NPAN0 ? (size_t)DM * NUP : (size_t)0) + (((PAN_R0(p_) >> 7) & 1) * FF + (PAN_R0(p_) >> 8) * 128 + (PAN_R0(p_) & 127)) + 4 * c8 + (size_t)(2 * r) * NUP)
#define PAN_LOAD(dst_, src_, b_) do { const float* q_ = (src_) + (size_t)(512 * (b_)) * NUP; asm volatile("" : "+v"(q_));     \
        _Pragma("unroll") for (int i = 0; i < 8; ++i) dst_[i] = __builtin_nontemporal_load((const GAS f32x4*)(q_ + (size_t)(128 * (i >> 1) + (i & 1)) * NUP)); } while (0)
#define PAN_PUT(src_, b_) do { \
        _Pragma("unroll") for (int i = 0; i < 4; ++i) { const unsigned gw = *(const LAS unsigned*)(gl + 4 * (r + 64 * (4 * (b_) + i))); const float ge = xlo(gw), go = xhi(gw); \
            const f32x4 a = src_[2 * i] * ge, c = src_[2 * i + 1] * go; \
            am0 = fmaxf(am0, fmaxf(fabsf(a.x), fabsf(c.x))); am1 = fmaxf(am1, fmaxf(fabsf(a.y), fabsf(c.y))); am2 = fmaxf(am2, fmaxf(fabsf(a.z), fabsf(c.z))); am3 = fmaxf(am3, fmaxf(fabsf(a.w), fabsf(c.w))); \
            LAS unsigned char* d = pan + (2 * c8) * 8192 + (((unsigned)(4 * (r + 64 * (4 * (b_) + i)))) ^ ((unsigned)c8 << 5)); \
            *(LAS unsigned*)(d) = xpk(a.x, c.x); *(LAS unsigned*)(d + 8192) = xpk(a.y, c.y); pz[4 * (b_) + i] = xpk(a.z, c.z); pw[4 * (b_) + i] = xpk(a.w, c.w); } } while (0)
#define PAN_QUANT(hi_) do { int tq = threadIdx.x; asm volatile("" : "+v"(tq)); const int slot = tq >> 5, l = tq & 31, col = 4 * (slot >> 1) + 2 * (hi_) + (slot & 1); const float mx = __uint_as_float(cmax[col]); const float inv = mx > 0.f ? 127.0f / mx : 0.f; \
        const unsigned key = (unsigned)(slot >> 1) << 5; GAS v2u* qo = (GAS v2u*)(Q + (size_t)(r0 + col) * LDQ); \
        _Pragma("unroll 4") for (int i = 0; i < 16; ++i) { const int ch = l + 32 * i; const v4u w = *(const LAS v4u*)(pan + slot * 8192 + (((unsigned)(16 * ch)) ^ key)); \
            v2u o; o.x = q4(xlo(w.x), xhi(w.x), xlo(w.y), xhi(w.y), inv); o.y = q4(xlo(w.z), xhi(w.z), xlo(w.w), xhi(w.w), inv); qo[ch] = o; } \
        if (l == 0) sc[r0 + col] = mx * (1.0f / 127.0f); } while (0)
    int p = first + rank; if (p >= end) return;
    f32x4 v0[8], v1[8]; unsigned pz[32], pw[32];
    LAS unsigned char* gl = F.lds + LDSCTL_OFF + 1280;
    int cur = -1;
    PAN_LOAD(v0, PAN_SRC(p), 0); PAN_LOAD(v1, PAN_SRC(p), 1);
    __syncthreads();
    for (; p < end; p += nwg) {
        const bool l1 = p >= NPAN0; const int r0 = PAN_R0(p);
        if ((int)l1 != cur) { cur = (int)l1; const float* gain = in[16] + (l1 ? DM : 0);
            for (int i = t; i < DM / 2; i += 512) *(LAS unsigned*)(gl + 4 * i) = xpk(gain[2 * i], gain[2 * i + 1]);
            __syncthreads(); }
        unsigned char* Q = ws + (l1 ? WS_WQ1 : WS_WQ0); float* sc = (float*)(ws + (l1 ? WS_WSC1 : WS_WSC0));
        { int tz_ = threadIdx.x; asm volatile("" : "+v"(tz_)); if (tz_ < 32) cmax[tz_] = 0u; }
        float am0 = 0.f, am1 = 0.f, am2 = 0.f, am3 = 0.f;
        const float* src = PAN_SRC(p); const int pnx = (p + nwg < end) ? p + nwg : p; const float* srn = PAN_SRC(pnx);
        PAN_PUT(v0, 0); asm volatile("" ::: "memory"); PAN_LOAD(v0, src, 2);
        PAN_PUT(v1, 1); asm volatile("" ::: "memory"); PAN_LOAD(v1, src, 3);
        PAN_PUT(v0, 2); asm volatile("" ::: "memory"); PAN_LOAD(v0, src, 4);
        PAN_PUT(v1, 3); asm volatile("" ::: "memory"); PAN_LOAD(v1, src, 5);
        PAN_PUT(v0, 4); asm volatile("" ::: "memory"); PAN_LOAD(v0, src, 6);
        PAN_PUT(v1, 5); asm volatile("" ::: "memory"); PAN_LOAD(v1, src, 7);
        PAN_PUT(v0, 6); asm volatile("" ::: "memory"); PAN_LOAD(v0, srn, 0);
        PAN_PUT(v1, 7); asm volatile("" ::: "memory"); PAN_LOAD(v1, srn, 1);
#pragma unroll
        for (int o = 8; o < 64; o <<= 1) { am0 = fmaxf(am0, __shfl_xor(am0, o)); am1 = fmaxf(am1, __shfl_xor(am1, o)); am2 = fmaxf(am2, __shfl_xor(am2, o)); am3 = fmaxf(am3, __shfl_xor(am3, o)); }
        __syncthreads();
        if (F.lane < 8) { atomicMax((unsigned*)(cmax + 4 * c8), __float_as_uint(am0)); atomicMax((unsigned*)(cmax + 4 * c8 + 1), __float_as_uint(am1)); atomicMax((unsigned*)(cmax + 4 * c8 + 2), __float_as_uint(am2)); atomicMax((unsigned*)(cmax + 4 * c8 + 3), __float_as_uint(am3)); }
        __syncthreads();
        PAN_QUANT(0);
        __syncthreads();
#pragma unroll
        for (int i = 0; i < 32; ++i) { LAS unsigned char* d = pan + (2 * c8) * 8192 + (((unsigned)(4 * (r + 64 * i))) ^ ((unsigned)c8 << 5)); *(LAS unsigned*)(d) = pz[i]; *(LAS unsigned*)(d + 8192) = pw[i]; }
        __syncthreads();
        PAN_QUANT(1);
        __syncthreads();
    }
#undef PAN_R0
#undef PAN_SRC
#undef PAN_LOAD
#undef PAN_PUT
#undef PAN_QUANT
}
__device__ __forceinline__ void x0_rows(Frame& F, const float* src, bf16* xb, bf16* xb2, ssq_t* ss) {
    const int gw = F.vcu * NWAVES + F.wave, NGW = F.G * NWAVES;
    for (int m = gw; m < M; m += NGW) {
        const GAS f32x4* xr = (const GAS f32x4*)(src + (size_t)m * DM) + F.lane;
        GAS unsigned long long* o8 = (GAS unsigned long long*)(xb + (size_t)m * LDX) + F.lane; float s = 0.f;
        GAS unsigned long long* p8 = (GAS unsigned long long*)(xb2 + (size_t)m * LDX) + F.lane;
#pragma unroll
        for (int j = 0; j < 16; ++j) { const f32x4 v = xr[64 * j]; const unsigned w0 = xpk(v.x, v.y), w1 = xpk(v.z, v.w); o8[64 * j] = (unsigned long long)w0 | ((unsigned long long)w1 << 32); { const unsigned b0 = pk2(v.x, v.y), b1 = pk2(v.z, v.w); p8[64 * j] = (unsigned long long)b0 | ((unsigned long long)b1 << 32); }
            const float a = xlo(w0), b = xhi(w0), c = xlo(w1), d = xhi(w1); s += (a * a + b * b) + (c * c + d * d); }
        s = wave_sum(s); if (F.lane == 0) ss[m] = ss_fix(s);
    }
}
__device__ __forceinline__ void final_rows(Frame& F, const bf16* xb, const ssq_t* ss, const float* gain, float* dst) {
    const int gw = F.vcu * NWAVES + F.wave, NGW = F.G * NWAVES;
    int lane_ = threadIdx.x; asm volatile("" : "+v"(lane_)); lane_ &= 63;
    for (int m = gw; m < M; m += NGW) {
        const float rstd = 1.0f / sqrtf(ss_get(ss, m) * (1.0f / DM) + EPS);
        const GAS v4u* xr = (const GAS v4u*)(xb + (size_t)m * LDX) + lane_; const GAS f32x4* gr = (const GAS f32x4*)gain + 2 * lane_; GAS f32x4* o = (GAS f32x4*)(dst + (size_t)m * DM) + 2 * lane_;
        v4u w[8];
#pragma unroll
        for (int j = 0; j < 8; ++j) w[j] = xr[64 * j];
#pragma unroll
        for (int j = 0; j < 8; ++j) { const f32x4 g0 = gr[128 * j], g1 = gr[128 * j + 1]; f32x4 r0, r1;
            r0.x = xlo(w[j].x) * rstd * g0.x; r0.y = xhi(w[j].x) * rstd * g0.y; r0.z = xlo(w[j].y) * rstd * g0.z; r0.w = xhi(w[j].y) * rstd * g0.w;
            r1.x = xlo(w[j].z) * rstd * g1.x; r1.y = xhi(w[j].z) * rstd * g1.y; r1.z = xlo(w[j].w) * rstd * g1.z; r1.w = xhi(w[j].w) * rstd * g1.w;
            o[128 * j] = r0; o[128 * j + 1] = r1; }
    }
}
__device__ __forceinline__ float wave_max(float v) {
#pragma unroll
    for (int o = 1; o < 64; o <<= 1) v = fmaxf(v, __shfl_xor(v, o));
    return v;
}
template <bool XH> __device__ __forceinline__ float qlo(unsigned w) { if constexpr (XH) return xlo(w); else return bf_lo(w); }
template <bool XH> __device__ __forceinline__ float qhi(unsigned w) { if constexpr (XH) return xhi(w); else return bf_hi(w); }
template <bool XH>
__device__ __forceinline__ void quant_rows(Frame& F, const bf16* X, int row0, int nrows, int ld, unsigned char* Q, float* scale, const ssq_t* ss, int gw, int NGW) {
    for (int m = row0 + gw; m < nrows; m += 2 * NGW) {
        const int m1 = m + NGW; const bool two = m1 < nrows; const int mb = two ? m1 : m;
        const GAS v4u* xr = (const GAS v4u*)(X + (size_t)m * ld) + F.lane; const GAS v4u* xs = (const GAS v4u*)(X + (size_t)mb * ld) + F.lane;
        v4u w[8], z[8]; float mx = 0.f, my = 0.f;
#pragma unroll
        for (int j = 0; j < 8; ++j) w[j] = xr[64 * j];
#pragma unroll
        for (int j = 0; j < 8; ++j) z[j] = xs[64 * j];
        float rs0 = 1.0f, rs1 = 1.0f;
        if (ss) { rs0 = 1.0f / sqrtf(ss_get(ss, m) * (1.0f / DM) + EPS); rs1 = 1.0f / sqrtf(ss_get(ss, mb) * (1.0f / DM) + EPS); }
#pragma unroll
        for (int j = 0; j < 8; ++j) {
            mx = fmaxf(mx, fmaxf(fmaxf(fabsf(qlo<XH>(w[j].x)), fabsf(qhi<XH>(w[j].x))), fmaxf(fabsf(qlo<XH>(w[j].y)), fabsf(qhi<XH>(w[j].y)))));
            mx = fmaxf(mx, fmaxf(fmaxf(fabsf(qlo<XH>(w[j].z)), fabsf(qhi<XH>(w[j].z))), fmaxf(fabsf(qlo<XH>(w[j].w)), fabsf(qhi<XH>(w[j].w))))); }
#pragma unroll
        for (int j = 0; j < 8; ++j) {
            my = fmaxf(my, fmaxf(fmaxf(fabsf(qlo<XH>(z[j].x)), fabsf(qhi<XH>(z[j].x))), fmaxf(fabsf(qlo<XH>(z[j].y)), fabsf(qhi<XH>(z[j].y)))));
            my = fmaxf(my, fmaxf(fmaxf(fabsf(qlo<XH>(z[j].z)), fabsf(qhi<XH>(z[j].z))), fmaxf(fabsf(qlo<XH>(z[j].w)), fabsf(qhi<XH>(z[j].w))))); }
        mx = wave_max(mx); my = wave_max(my);
        const float inv = mx > 0.f ? 127.0f / mx : 0.f, inw = my > 0.f ? 127.0f / my : 0.f;
        GAS v2u* qo = (GAS v2u*)(Q + (size_t)m * LDQ) + F.lane;
#pragma unroll
        for (int j = 0; j < 8; ++j) { v2u o; o.x = q4(qlo<XH>(w[j].x), qhi<XH>(w[j].x), qlo<XH>(w[j].y), qhi<XH>(w[j].y), inv); o.y = q4(qlo<XH>(w[j].z), qhi<XH>(w[j].z), qlo<XH>(w[j].w), qhi<XH>(w[j].w), inv); qo[64 * j] = o; }
        if (F.lane == 0) scale[m] = mx * (1.0f / 127.0f) * rs0;
        if (two) {
            GAS v2u* qp = (GAS v2u*)(Q + (size_t)m1 * LDQ) + F.lane;
#pragma unroll
            for (int j = 0; j < 8; ++j) { v2u o; o.x = q4(qlo<XH>(z[j].x), qhi<XH>(z[j].x), qlo<XH>(z[j].y), qhi<XH>(z[j].y), inw); o.y = q4(qlo<XH>(z[j].z), qhi<XH>(z[j].z), qlo<XH>(z[j].w), qhi<XH>(z[j].w), inw); qp[64 * j] = o; }
            if (F.lane == 0) scale[m1] = my * (1.0f / 127.0f) * rs1;
        }
    }
}
__device__ __forceinline__ int t5_bucket(int n) { if (n < 16) return n; const int b = 16 + (int)(__log2f((float)n * 0.0625f) * (16.0f / 3.0f)); return b < 31 ? b : 31; }

typedef float f32x16 __attribute__((ext_vector_type(16)));
typedef __bf16 bf16x2_t __attribute__((ext_vector_type(2)));
typedef float f32x2_t __attribute__((ext_vector_type(2)));
__device__ __forceinline__ unsigned cvtpk(float lo, float hi) { f32x2_t v = {lo, hi}; bf16x2_t b = __builtin_convertvector(v, bf16x2_t); return __builtin_bit_cast(unsigned, b); }
#define MFMA32(a, b, c) __builtin_amdgcn_mfma_f32_32x32x16_bf16((a), (b), (c), 0, 0, 0)
constexpr int AT_KSTR = 144, AT_VSTR = 528;
constexpr int AT_LDS_K = 0, AT_LDS_V = 256 * AT_KSTR, AT_LDS_B = AT_LDS_V + 64 * AT_VSTR, AT_LDS_END = AT_LDS_B + NWAVES * 768;
static_assert(AT_LDS_END <= RING_BYTES, "attention LDS map");
__device__ __forceinline__ int crow16(int i, int h) { return (i & 3) + 8 * (i >> 2) + 4 * h; }
__device__ __forceinline__ void attn_mfma(Frame& F, const bf16* QKV, const float* sinks, const float* rel_bias, bf16* AO) {
    LAS unsigned char* Ks = F.lds + AT_LDS_K; LAS unsigned char* Vt = F.lds + AT_LDS_V; LAS float* tb = (LAS float*)(F.lds + AT_LDS_B + F.wave * 768);
    const int lane = F.lane, r = lane & 31, h = lane >> 5, w = F.wave;
    const float LOG2E = 1.4426950408889634f, SC = 0.125f * LOG2E;
    for (int unit = (int)blockIdx.x; unit < BATCH * 32 * NKV; unit += F.G) {
        const int kvh = unit & 7, nb = (unit >> 3) & 31, b = unit >> 8, head = kvh * 8 + w;
        for (int e = lane; e < 192; e += 64) { const int dist = e - 32; tb[e] = (dist >= 0 && dist < 128) ? rel_bias[t5_bucket(dist) * NH + head] * LOG2E : -1e30f; }
        const float sink2 = sinks[head] * LOG2E;
        const long long row0 = (long long)b * SEQ + (nb - 1) * 128;
#pragma unroll
        for (int i = 0; i < 4; ++i) {
            const int c = F.tid + 512 * i, key = c >> 3, dc = c & 7;
            if (nb > 0 || key >= 128) {
                const bf16* src = QKV + (size_t)(row0 + key) * QKVW + DM + kvh * 64 + dc * 8;
                const v4u kk = *(const v4u*)src, vv = *(const v4u*)(src + 512);
                *(LAS v4u*)(Ks + key * AT_KSTR + dc * 16) = kk;
                LAS unsigned short* vp = (LAS unsigned short*)(Vt + (dc * 8) * AT_VSTR + key * 2);
                vp[0 * 264] = (unsigned short)(vv.x & 0xffffu); vp[1 * 264] = (unsigned short)(vv.x >> 16); vp[2 * 264] = (unsigned short)(vv.y & 0xffffu); vp[3 * 264] = (unsigned short)(vv.y >> 16);
                vp[4 * 264] = (unsigned short)(vv.z & 0xffffu); vp[5 * 264] = (unsigned short)(vv.z >> 16); vp[6 * 264] = (unsigned short)(vv.w & 0xffffu); vp[7 * 264] = (unsigned short)(vv.w >> 16);
            }
        }
        bf16x8 qf[4];
        { const bf16* qp = QKV + ((size_t)b * SEQ + nb * 128 + r) * QKVW + head * 64 + 8 * h;
#pragma unroll
          for (int ks = 0; ks < 4; ++ks) qf[ks] = *(const bf16x8*)(qp + 16 * ks); }
        __syncthreads();
#pragma unroll 1
        for (int qt = 0; qt < 4; ++qt) {
            const size_t qrow = (size_t)b * SEQ + nb * 128 + 32 * qt + r;
            bf16x8 qn[4];
            { const bf16* qp = QKV + (qrow + (qt < 3 ? 32 : 0)) * QKVW + head * 64 + 8 * h;
#pragma unroll
              for (int ks = 0; ks < 4; ++ks) qn[ks] = *(const bf16x8*)(qp + 16 * ks); }
            f32x16 S[5];
            float m = sink2;
#pragma unroll
            for (int e = 0; e < 5; ++e) {
                const int kb = qt + e;
                if (nb > 0 || kb >= 4) {
                    f32x16 acc;
#pragma unroll
                    for (int i = 0; i < 16; ++i) acc[i] = 0.f;
#pragma unroll
                    for (int ks = 0; ks < 4; ++ks) { const bf16x8 a = *(const LAS bf16x8*)(Ks + (32 * kb + r) * AT_KSTR + (16 * ks + 8 * h) * 2); acc = MFMA32(a, qf[ks], acc); }
#pragma unroll
                    for (int i = 0; i < 16; ++i) { const float s = acc[i] * SC + tb[160 - 32 * e + r - crow16(i, h)]; S[e][i] = s; m = fmaxf(m, s); }
                } else {
#pragma unroll
                    for (int i = 0; i < 16; ++i) S[e][i] = -1e30f;
                }
            }
            m = fmaxf(m, __shfl_xor(m, 32));
            float l = 0.f;
#pragma unroll
            for (int e = 0; e < 5; ++e)
#pragma unroll
                for (int i = 0; i < 16; ++i) { const float p = __builtin_amdgcn_exp2f(S[e][i] - m); S[e][i] = p; l += p; }
            l += __shfl_xor(l, 32);
            l += __builtin_amdgcn_exp2f(sink2 - m);
            f32x16 O0, O1;
#pragma unroll
            for (int i = 0; i < 16; ++i) { O0[i] = 0.f; O1[i] = 0.f; }
#pragma unroll
            for (int e = 0; e < 5; ++e) {
                const int kb = qt + e;
                if (nb > 0 || kb >= 4) {
#pragma unroll
                    for (int s = 0; s < 2; ++s) {
                        v4u pw; pw.x = cvtpk(S[e][8 * s], S[e][8 * s + 1]); pw.y = cvtpk(S[e][8 * s + 2], S[e][8 * s + 3]); pw.z = cvtpk(S[e][8 * s + 4], S[e][8 * s + 5]); pw.w = cvtpk(S[e][8 * s + 6], S[e][8 * s + 7]);
                        const bf16x8 pb = __builtin_bit_cast(bf16x8, pw);
                        const LAS unsigned char* vb = Vt + r * AT_VSTR + (32 * kb + 16 * s + 4 * h) * 2;
                        { const v2u lo = *(const LAS v2u*)vb, hi = *(const LAS v2u*)(vb + 16); v4u aw; aw.x = lo.x; aw.y = lo.y; aw.z = hi.x; aw.w = hi.y; O0 = MFMA32(__builtin_bit_cast(bf16x8, aw), pb, O0); }
                        { const v2u lo = *(const LAS v2u*)(vb + 32 * AT_VSTR), hi = *(const LAS v2u*)(vb + 32 * AT_VSTR + 16); v4u aw; aw.x = lo.x; aw.y = lo.y; aw.z = hi.x; aw.w = hi.y; O1 = MFMA32(__builtin_bit_cast(bf16x8, aw), pb, O1); }
                    }
                }
            }
            const float inv = 1.0f / l;
            bf16* op = AO + qrow * LDX + head * 64 + 4 * h;
#pragma unroll
            for (int i4 = 0; i4 < 4; ++i4) {
                v2u o; o.x = cvtpk(O0[4 * i4] * inv, O0[4 * i4 + 1] * inv); o.y = cvtpk(O0[4 * i4 + 2] * inv, O0[4 * i4 + 3] * inv); *(v2u*)(op + 8 * i4) = o;
                o.x = cvtpk(O1[4 * i4] * inv, O1[4 * i4 + 1] * inv); o.y = cvtpk(O1[4 * i4 + 2] * inv, O1[4 * i4 + 3] * inv); *(v2u*)(op + 32 + 8 * i4) = o;
            }
#pragma unroll
            for (int ks = 0; ks < 4; ++ks) qf[ks] = qn[ks];
        }
        __syncthreads();
    }
}
__device__ __forceinline__ float gelu_tanh(float x) {
    const float z = 0.7978845608028654f * (x + 0.044715f * x * x * x);
    return x * __builtin_amdgcn_rcpf(1.0f + __builtin_amdgcn_exp2f(-2.0f * 1.4426950408889634f * z));
}
constexpr int S5_KT_ELEMS = 33 * 256, S5_BE_ELEMS = 128 * 512, S5_CP_ELEMS = 512 * 128;
constexpr int S5_XE_STRIDE = 132;
constexpr int S5_LDS_XE = 0, S5_LDS_KT = 128 * S5_XE_STRIDE * 4;
static_assert(S5_LDS_KT + S5_KT_ELEMS * 2 <= RING_BYTES, "S5 LDS map");

__device__ __forceinline__ void s5_tables(Frame& F, const float* lam_re, const float* lam_im, const float* log_step, const float* b_re, const float* b_im,
                                          const float* c_re, const float* c_im, bf16* KT, bf16* BE, bf16* CP, float* AT, int g0, int gstep) {
    LAS float* apr = (LAS float*)(F.lds); LAS float* api = apr + 33 * 64; LAS float* Cr = api + 33 * 64; LAS float* Ci = Cr + 1024; LAS float* Br = Ci + 1024; LAS float* Bi = Br + 64 * 17;
    LAS float* ffr = Bi + 64 * 17; LAS float* ffi = ffr + 64;
    const int tid = F.tid;
    for (int g = g0; g < SG; g += gstep) {
        const float delta = expf(log_step[g]);
        for (int e = tid; e < 33 * 64; e += NWAVES * 64) { const int tau = e >> 6, p = e & 63; const float lr = lam_re[g * SP + p], li = lam_im[g * SP + p];
            double ang = (double)li * (double)delta * (double)tau; ang -= 6.283185307179586 * rint(ang * 0.15915494309189535);
            float sn, cs; sincosf((float)ang, &sn, &cs); const float mag = expf(lr * delta * (float)tau); apr[p * 33 + tau] = mag * cs; api[p * 33 + tau] = mag * sn; }
        for (int e = tid; e < 1024; e += NWAVES * 64) { const int c = e >> 6, p = e & 63; Cr[p * 16 + c] = c_re[(size_t)g * 1024 + e]; Ci[p * 16 + c] = c_im[(size_t)g * 1024 + e]; }
        if (tid < 64) { const int p = tid; const float lr = lam_re[g * SP + p], li = lam_im[g * SP + p];
            double ang = (double)li * (double)delta; ang -= 6.283185307179586 * rint(ang * 0.15915494309189535);
            const float y = (float)ang, x = lr * delta; float sn, cs, sh, ch; sincosf(y, &sn, &cs); sincosf(0.5f * y, &sh, &ch);
            const float em1 = expm1f(x); const float nr = em1 * cs - 2.0f * sh * sh, ni = (em1 + 1.0f) * sn, den = lr * lr + li * li;
            ffr[p] = (nr * lr + ni * li) / den; ffi[p] = (ni * lr - nr * li) / den; }
        __syncthreads();
        for (int e = tid; e < 1024; e += NWAVES * 64) { const int p = e >> 4; const float Bre = b_re[(size_t)g * 1024 + e], Bim = b_im[(size_t)g * 1024 + e], fr = ffr[p], fi = ffi[p];
            Br[p * 17 + (e & 15)] = fr * Bre - fi * Bim; Bi[p * 17 + (e & 15)] = fr * Bim + fi * Bre; }
        __syncthreads();
        {
            const int tau = tid >> 4, c = tid & 15; float acc[16];
#pragma unroll
            for (int cc = 0; cc < 16; ++cc) acc[cc] = 0.f;
            for (int p = 0; p < 64; ++p) { const float cr = Cr[p * 16 + c], ci = Ci[p * 16 + c], pr = apr[p * 33 + tau], pi = api[p * 33 + tau];
                const float er = cr * pr - ci * pi, ei = cr * pi + ci * pr;
#pragma unroll
                for (int cc = 0; cc < 16; ++cc) acc[cc] += er * Br[p * 17 + cc] - ei * Bi[p * 17 + cc]; }
            v4u o0, o1; o0.x = pk2(acc[0], acc[1]); o0.y = pk2(acc[2], acc[3]); o0.z = pk2(acc[4], acc[5]); o0.w = pk2(acc[6], acc[7]);
            o1.x = pk2(acc[8], acc[9]); o1.y = pk2(acc[10], acc[11]); o1.z = pk2(acc[12], acc[13]); o1.w = pk2(acc[14], acc[15]);
            v4u* dst = (v4u*)(KT + (size_t)g * S5_KT_ELEMS + (tau + 1) * 256 + c * 16); dst[0] = o0; dst[1] = o1;
            if (tid < 16) { v4u* z = (v4u*)(KT + (size_t)g * S5_KT_ELEMS + tid * 16); const v4u zz = {0u, 0u, 0u, 0u}; z[0] = zz; z[1] = zz; }
        }
        {
            const int pp = tid >> 2, sq = tid & 3, p = pp & 63; const bool im = pp >= 64;
            for (int s = 8 * sq; s < 8 * sq + 8; ++s) { const float pr = apr[p * 33 + (31 - s)], pi = api[p * 33 + (31 - s)]; float v[16];
#pragma unroll
                for (int cc = 0; cc < 16; ++cc) { const float br = Br[p * 17 + cc], bi = Bi[p * 17 + cc]; v[cc] = im ? (pr * bi + pi * br) : (pr * br - pi * bi); }
                v4u o0, o1; o0.x = pk2(v[0], v[1]); o0.y = pk2(v[2], v[3]); o0.z = pk2(v[4], v[5]); o0.w = pk2(v[6], v[7]);
                o1.x = pk2(v[8], v[9]); o1.y = pk2(v[10], v[11]); o1.z = pk2(v[12], v[13]); o1.w = pk2(v[14], v[15]);
                v4u* dst = (v4u*)(BE + (size_t)g * S5_BE_ELEMS + (size_t)pp * 512 + s * 16); dst[0] = o0; dst[1] = o1; }
        }
        {
            const int t = tid >> 4, c = tid & 15; bf16* dst = CP + (size_t)g * S5_CP_ELEMS + (size_t)tid * 128;
            for (int p0 = 0; p0 < 64; p0 += 8) { float er[8], ei[8];
#pragma unroll
                for (int j = 0; j < 8; ++j) { const int p = p0 + j; const float cr = Cr[p * 16 + c], ci = Ci[p * 16 + c], pr = apr[p * 33 + t + 1], pi = api[p * 33 + t + 1];
                    er[j] = cr * pr - ci * pi; ei[j] = -(cr * pi + ci * pr); }
                v4u o; o.x = pk2(er[0], er[1]); o.y = pk2(er[2], er[3]); o.z = pk2(er[4], er[5]); o.w = pk2(er[6], er[7]); *(v4u*)(dst + p0) = o;
                o.x = pk2(ei[0], ei[1]); o.y = pk2(ei[2], ei[3]); o.z = pk2(ei[4], ei[5]); o.w = pk2(ei[6], ei[7]); *(v4u*)(dst + 64 + p0) = o; }
        }
        if (tid < 64) { AT[(size_t)g * 128 + tid * 2] = apr[tid * 33 + 32]; AT[(size_t)g * 128 + tid * 2 + 1] = api[tid * 33 + 32]; }
        __syncthreads();
    }
}

__device__ __forceinline__ bf16x8 pack8(const f32x4 lo, const f32x4 hi) {
    v4u w; w.x = pg8::cvt_pk_bf16(lo[0], lo[1]); w.y = pg8::cvt_pk_bf16(lo[2], lo[3]); w.z = pg8::cvt_pk_bf16(hi[0], hi[1]); w.w = pg8::cvt_pk_bf16(hi[2], hi[3]);
    return __builtin_bit_cast(bf16x8, w);
}
constexpr int S5_US_STRIDE = 1056;
constexpr int S5_LDS_US = S5_LDS_KT + S5_KT_ELEMS * 2;
static_assert(S5_LDS_US % 16 == 0 && S5_LDS_US + 32 * S5_US_STRIDE <= RING_BYTES, "S5 LDS map");
__device__ __forceinline__ void s5_mixer(Frame& F, const ssq_t* ss, const float* gain, const bf16* HS, const bf16* KT, const bf16* BE, const bf16* CP, const float* AT, const float* d_skip, bf16* YG) {
    LAS float* XE = (LAS float*)(F.lds + S5_LDS_XE);
    LAS unsigned char* KTl = F.lds + S5_LDS_KT;
    LAS unsigned char* US = F.lds + S5_LDS_US;
    const int lane = F.lane, r = lane & 31, h = lane >> 5, w = F.wave;
    for (int u = F.vcu; u < 2 * SG; u += F.G) {
        const int g = u & (SG - 1), b = u >> 8;
        const bf16* Hs = HS + (size_t)u * SEQ * SGC;
        const v4u* slab4 = (const v4u*)Hs;
        int sdst[4];
#pragma unroll
        for (int i = 0; i < 4; ++i) { const int q = F.tid + 512 * i, tok = q >> 1; sdst[i] = (tok >> 5) * S5_US_STRIDE + (tok & 31) * 32 + (q & 1) * 16; }
        float gn[8];
#pragma unroll
        for (int c = 0; c < 8; ++c) gn[c] = gain[g * SGC + 8 * (F.tid & 1) + c];
        const ssq_t* ssb = ss + (size_t)b * SEQ;
#define S5_STAGE_LOAD(nb_) do { _Pragma("unroll") for (int i = 0; i < 4; ++i) { st[i] = slab4[(nb_) * 2048 + F.tid + 512 * i]; sv[i] = ss_get(ssb, (nb_) * 1024 + ((F.tid + 512 * i) >> 1)); } } while (0)
#define S5_STAGE_STORE() do { _Pragma("unroll") for (int i = 0; i < 4; ++i) { const float rs = __builtin_amdgcn_rsqf(sv[i] * (1.0f / DM) + EPS); v4u o; \
            o.x = pk2(xlo(st[i].x) * rs * gn[0], xhi(st[i].x) * rs * gn[1]); o.y = pk2(xlo(st[i].y) * rs * gn[2], xhi(st[i].y) * rs * gn[3]); \
            o.z = pk2(xlo(st[i].z) * rs * gn[4], xhi(st[i].z) * rs * gn[5]); o.w = pk2(xlo(st[i].w) * rs * gn[6], xhi(st[i].w) * rs * gn[7]); \
            *(LAS v4u*)(US + sdst[i]) = o; } } while (0)
        const LAS unsigned char* ufrag = US + r * S5_US_STRIDE + 16 * h;
        { const v4u* src = (const v4u*)(KT + (size_t)g * S5_KT_ELEMS); LAS v4u* dst = (LAS v4u*)KTl; for (int e = F.tid; e < S5_KT_ELEMS * 2 / 16; e += NWAVES * 64) dst[e] = src[e];
 }
        __syncthreads();
        {
            const int mb = w & 3, sh = w >> 2;
            bf16x8 ber[16];
            { const bf16* BEb = BE + (size_t)g * S5_BE_ELEMS + (size_t)(32 * mb + r) * 512 + (16 * sh) * 16 + 8 * h;
#pragma unroll
              for (int si = 0; si < 16; ++si) ber[si] = *(const bf16x8*)(BEb + si * 16); }
            v4u st[4]; float sv[4];
            S5_STAGE_LOAD(0);
#pragma unroll 1
            for (int nb = 0; nb < 4; ++nb) {
                S5_STAGE_STORE();
                __syncthreads();
                if (nb < 3) S5_STAGE_LOAD(nb + 1);
                f32x16 acc0, acc1;
#pragma unroll
                for (int i = 0; i < 16; ++i) { acc0[i] = 0.f; acc1[i] = 0.f; }
#pragma unroll
                for (int si = 0; si < 16; si += 2) { const bf16x8 u0 = *(const LAS bf16x8*)(ufrag + (16 * sh + si) * 32), u1 = *(const LAS bf16x8*)(ufrag + (16 * sh + si + 1) * 32);
                    acc0 = MFMA32(ber[si], u0, acc0); acc1 = MFMA32(ber[si + 1], u1, acc1); }
                LAS float* xrow = XE + (32 * nb + r) * S5_XE_STRIDE + 32 * mb + 4 * h;
                if (sh == 0) {
#pragma unroll
                    for (int i4 = 0; i4 < 4; ++i4) *(LAS f32x4*)(xrow + 8 * i4) = (f32x4){acc0[4 * i4] + acc1[4 * i4], acc0[4 * i4 + 1] + acc1[4 * i4 + 1], acc0[4 * i4 + 2] + acc1[4 * i4 + 2], acc0[4 * i4 + 3] + acc1[4 * i4 + 3]};
                }
                __syncthreads();
                if (sh == 1) {
#pragma unroll
                    for (int i4 = 0; i4 < 4; ++i4) { const f32x4 o = *(const LAS f32x4*)(xrow + 8 * i4);
                        *(LAS f32x4*)(xrow + 8 * i4) = (f32x4){o[0] + acc0[4 * i4] + acc1[4 * i4], o[1] + acc0[4 * i4 + 1] + acc1[4 * i4 + 1], o[2] + acc0[4 * i4 + 2] + acc1[4 * i4 + 2], o[3] + acc0[4 * i4 + 3] + acc1[4 * i4 + 3]}; }
                }
            }
            __syncthreads();
        }
        if (w == 0) {
            const float atr = AT[(size_t)g * 128 + lane * 2], ati = AT[(size_t)g * 128 + lane * 2 + 1];
            float xr = 0.f, xi = 0.f;
            for (int k0 = 0; k0 < 127; k0 += 8) {
                float er[8], ei[8];
#pragma unroll
                for (int i = 0; i < 8; ++i) if (k0 + i < 127) { er[i] = XE[(k0 + i) * S5_XE_STRIDE + lane]; ei[i] = XE[(k0 + i) * S5_XE_STRIDE + 64 + lane]; }
#pragma unroll
                for (int i = 0; i < 8; ++i) if (k0 + i < 127) { const float nxr = atr * xr - ati * xi + er[i], nxi = atr * xi + ati * xr + ei[i]; xr = nxr; xi = nxi; er[i] = xr; ei[i] = xi; }
#pragma unroll
                for (int i = 0; i < 8; ++i) if (k0 + i < 127) { XE[(k0 + i) * S5_XE_STRIDE + lane] = er[i]; XE[(k0 + i) * S5_XE_STRIDE + 64 + lane] = ei[i]; }
            }
        }
        {
            const int jA = w, jB = 15 - w;
            bf16x8 cpa[8], cpb[8];
            { const bf16* CPg = CP + (size_t)g * S5_CP_ELEMS + (size_t)r * 128 + 8 * h;
#pragma unroll
              for (int ks = 0; ks < 8; ++ks) { cpa[ks] = *(const bf16x8*)(CPg + (size_t)(32 * jA) * 128 + 16 * ks); cpb[ks] = *(const bf16x8*)(CPg + (size_t)(32 * jB) * 128 + 16 * ks); } }
            const f32x4 dsk0 = *(const f32x4*)(d_skip + g * SGC + 4 * h), dsk1 = *(const f32x4*)(d_skip + g * SGC + 8 + 4 * h);
            const int ktl = ((r >> 4) * 256 + (r & 15) * 16 + 8 * h) * 2;
            v4u st[4]; float sv[4];
            S5_STAGE_LOAD(0);
            __syncthreads();
            {
#pragma unroll 1
            for (int nb = 0; nb < 4; ++nb) {
                S5_STAGE_STORE();
                __syncthreads();
                if (nb < 3) S5_STAGE_LOAD(nb + 1);
                const int kc = 32 * nb + r;
                f32x16 cA, cB;
#pragma unroll
                for (int i = 0; i < 16; ++i) { cA[i] = 0.f; cB[i] = 0.f; }
#pragma unroll
                for (int ks = 0; ks < 8; ++ks) {
                    f32x4 lo = {0.f, 0.f, 0.f, 0.f}, hi = {0.f, 0.f, 0.f, 0.f};
                    if (kc >= 1) { const LAS float* xp = XE + (kc - 1) * S5_XE_STRIDE + 16 * ks + 8 * h; lo = *(const LAS f32x4*)xp; hi = *(const LAS f32x4*)(xp + 4); }
                    const bf16x8 xb = pack8(lo, hi);
                    cA = MFMA32(cpa[ks], xb, cA); cB = MFMA32(cpb[ks], xb, cB);
                }
                const int nA = 2 * jA + 2, nB = 2 * jB + 2;
                const LAS unsigned char* ka = KTl + ktl + (2 * jA + 1) * 512; const LAS unsigned char* kb = KTl + ktl + (2 * jB + 1) * 512;
                {
#define S5_U(s_) (*(const LAS bf16x8*)(ufrag + (s_) * 32))
#define S5_KA(s_) (*(const LAS bf16x8*)(ka - (s_) * 512))
#define S5_KB(s_) (*(const LAS bf16x8*)(kb - (s_) * 512))
                    bf16x8 u0 = S5_U(0), u1 = S5_U(1), a0 = S5_KA(0), a1 = S5_KA(1), b0 = S5_KB(0), b1 = S5_KB(1);
#pragma unroll 1
                    for (int s = 0; s < nA; s += 2) {
                        const bf16x8 nu0 = S5_U(s + 2), nu1 = S5_U(s + 3), na0 = S5_KA(s + 2), na1 = S5_KA(s + 3), nb0 = S5_KB(s + 2), nb1 = S5_KB(s + 3);
                        cA = MFMA32(a0, u0, cA); cB = MFMA32(b0, u0, cB); cA = MFMA32(a1, u1, cA); cB = MFMA32(b1, u1, cB);
                        u0 = nu0; u1 = nu1; a0 = na0; a1 = na1; b0 = nb0; b1 = nb1;
                    }
#pragma unroll 1
                    for (int s = nA; s < nB; s += 2) {
                        const bf16x8 nu0 = S5_U(s + 2), nu1 = S5_U(s + 3), nb0 = S5_KB(s + 2), nb1 = S5_KB(s + 3);
                        cB = MFMA32(b0, u0, cB); cB = MFMA32(b1, u1, cB);
                        u0 = nu0; u1 = nu1; b0 = nb0; b1 = nb1;
                    }
#undef S5_U
#undef S5_KA
#undef S5_KB
                }
#define S5_EPI(cacc, jj) do { _Pragma("unroll") for (int i4 = 0; i4 < 4; ++i4) { \
                    const int t = 2 * (jj) + (i4 >> 1), c0i = 8 * (i4 & 1) + 4 * h; const size_t off = ((size_t)(b * SEQ + kc * 32 + t)) * LDX + g * SGC + c0i; \
                    const v2u uw = *(const LAS v2u*)(US + r * S5_US_STRIDE + t * 32 + c0i * 2); const f32x4 dk = (i4 & 1) ? dsk1 : dsk0; \
                    const float y0 = cacc[4 * i4] + dk[0] * bf_lo(uw.x), y1 = cacc[4 * i4 + 1] + dk[1] * bf_hi(uw.x), y2 = cacc[4 * i4 + 2] + dk[2] * bf_lo(uw.y), y3 = cacc[4 * i4 + 3] + dk[3] * bf_hi(uw.y); \
                    v2u ow; ow.x = pg8::cvt_pk_bf16(gelu_tanh(y0), gelu_tanh(y1)); ow.y = pg8::cvt_pk_bf16(gelu_tanh(y2), gelu_tanh(y3)); *(v2u*)(YG + off) = ow; } } while (0)
                S5_EPI(cA, jA); S5_EPI(cB, jB);
#undef S5_EPI
                __syncthreads();
            }
            }
        }
#undef S5_STAGE_LOAD
#undef S5_STAGE_STORE
    }
}
__device__ __forceinline__ void conv_fixup(Frame& F, const float* HEAD, const float* TAIL, const float* cw, const float* cb, bf16* ACT, const float* wsc) {
    const int gt = F.vcu * NWAVES * 64 + F.tid, NGT = F.G * NWAVES * 64;
    for (int it = gt; it < (M / 256) * FF; it += NGT) {
        const int blk = it / FF, f = it - blk * FF;
        const int nn = ((f >> 7) << 8) + (f & 127);
        float c0[2], c1[2];
#pragma unroll
        for (int bj = 0; bj < 2; ++bj) {
            const int col = bj * FF + f, nc = nn + bj * 128;
            const float sc = wsc ? wsc[nc] : 1.0f; const float w0 = cw[col] * sc, w1 = cw[NUP + col] * sc, w2 = cw[2 * NUP + col] * sc, bb = cb[col];
            float t0 = 0.f, t1 = 0.f;
            if ((blk & 15) != 0) {
            t0 = TAIL[((size_t)(blk - 1) * 2 + 0) * NUP + nc]; t1 = TAIL[((size_t)(blk - 1) * 2 + 1) * NUP + nc]; }
            const float h0 = HEAD[((size_t)blk * 2 + 0) * NUP + nc], h1 = HEAD[((size_t)blk * 2 + 1) * NUP + nc];
            c0[bj] = bb + w0 * t0 + w1 * t1 + w2 * h0;
            c1[bj] = bb + w0 * t1 + w1 * h0 + w2 * h1;
        }
        const float o0 = c0[0] * pg8::fast_sigmoid(c0[0]) * c0[1], o1 = c1[0] * pg8::fast_sigmoid(c1[0]) * c1[1];
        ACT[(size_t)(blk * 256) * LDACT + f] = (bf16)f2bf(o0);
        ACT[(size_t)(blk * 256 + 1) * LDACT + f] = (bf16)f2bf(o1);
    }
}

struct Args { const float* in[22]; float* out; unsigned char* ws; int ph_lo, ph_hi, li, pad; };
__global__ void __launch_bounds__(NWAVES * 64, 2) mk_fwd(Args args) {
    extern __shared__ __attribute__((aligned(16))) unsigned char lds[];
    Frame F;
    F.lds = (LAS unsigned char*)lds;
    F.MISC = (volatile LAS unsigned*)(F.lds + MISC_OFF);
    F.tid = threadIdx.x; F.lane = F.tid & 63; F.wave = __builtin_amdgcn_readfirstlane(F.tid >> 6);
    F.G = gridDim.x; { const int bx = blockIdx.x; F.vcu = (F.G % 8 == 0) ? (bx % 8) * (F.G / 8) + bx / 8 : bx; }
    unsigned char* ws = args.ws;
    F.ctl = (gu32*)(ws + WS_CTL);
    for (int u = F.tid; u < (LDS_BYTES - LDSCTL_OFF) / 4; u += NWAVES * 64) ((LAS unsigned*)(F.lds + LDSCTL_OFF))[u] = 0u;
    __syncthreads();
    XcdBarrier bar; bar.bar = (unsigned*)(F.ctl + CW_BAR); bar.x = 0; bar.st = nullptr;
    if (N_LAUNCHES == 1) bar = xcd_barrier_post((unsigned*)(F.ctl + CW_BAR), F.MISC + 8);
#define GRID_BAR() do { if (N_LAUNCHES == 1) xcd_barrier(bar); } while (0)
    const int lo = args.ph_lo, hi = args.ph_hi;
#define IN(k) (lo <= (k) && (k) < hi)
#define BOTH(k) (IN(k) && IN((k) + 1))
    const float* x_in = args.in[0];
    float* X = (float*)(ws + WS_X);
    bf16* XNB = (bf16*)(ws + WS_XNB);
    bf16* XN = (bf16*)(ws + WS_XN); bf16* QKV = (bf16*)(ws + WS_QKV); bf16* AO = (bf16*)(ws + WS_AO); bf16* ACT = (bf16*)(ws + WS_ACT);
    float* HEAD = (float*)(ws + WS_HEAD); float* TAIL = (float*)(ws + WS_TAIL);

    ssq_t* SS0 = (ssq_t*)(ws + WS_SS); ssq_t* SS1 = SS0 + M; ssq_t* SS2 = SS1 + M; ssq_t* SS3 = SS2 + M; ssq_t* SS4 = SS3 + M;
    const float INVD = 1.0f / DM;
    LAS float* TLX = (LAS float*)(F.lds + LDSCTL_OFF + 1024);
#ifndef CVT_P0
#define CVT_P0 10240
#endif
    static_assert(CVT_P0 >= CI_QKV && CVT_P0 <= CVT_ITEMS, "prologue share");
    const bool split = (F.G == 256);
    const bool defer = false;
    if (IN(0)) { if (!split) s5_tables(F, args.in[7], args.in[8], args.in[9], args.in[10], args.in[11], args.in[12], args.in[13], (bf16*)(ws + WS_S5KT), (bf16*)(ws + WS_S5BE), (bf16*)(ws + WS_S5CP), (float*)(ws + WS_S5AT), (int)blockIdx.x, F.G);
        convert_weights(F, args.in, ws, 0, split ? CVT_P0 : (defer ? CVT_NP : CVT_ITEMS), F.vcu * NWAVES + F.wave, F.G * NWAVES); if (!split) convert_panels(F, args.in, ws, 0, NPAN, (int)blockIdx.x, F.G); x0_rows(F, x_in, XN, XNB, SS0); if (BOTH(0)) GRID_BAR(); }
    if (IN(1)) { pg8::Gemm g{XNB, (const bf16*)(ws + WS_WQKV), M, QKVW, DM, LDX, LDW}; pg8::StaticOrder S;
#ifndef QKV_WGS
#define QKV_WGS 128
#endif
        const bool gemm_side = !split || (int)blockIdx.x < QKV_WGS;
        if (split) S.init(M, QKVW, QKV_WGS, (int)blockIdx.x); else S.init(M, QKVW, F.G, (int)blockIdx.x);
        pg8::EpiBf16Scale E{QKV, QKVW, pg8::RowScale{SS0, nullptr, INVD, EPS}};
#ifndef CVT_GSIDE
#define CVT_GSIDE 12288
#endif
#ifndef CVT_T4
#define CVT_T4 14336
#define CVT_T9 7168
#endif
        constexpr int CVT_TAIL = CVT_T4 + CVT_T9;
        static_assert(CVT_TAIL <= CI_DN && CVT_TAIL + CVT_GSIDE + CVT_P0 <= CVT_ITEMS, "deferred conversion items");
        const int cvt_tail = split ? CVT_TAIL : 0;
        if (gemm_side) { pg8::gemm_phase<pg8::EpiBf16Scale, pg8::StaticOrder, true, true>(F.lds + RING_OFF, g, S, E);
            if (split) convert_weights(F, args.in, ws, CVT_ITEMS - CVT_TAIL - CVT_GSIDE, CVT_GSIDE, (int)blockIdx.x * NWAVES + F.wave, QKV_WGS * NWAVES); }
        else { s5_tables(F, args.in[7], args.in[8], args.in[9], args.in[10], args.in[11], args.in[12], args.in[13], (bf16*)(ws + WS_S5KT), (bf16*)(ws + WS_S5BE), (bf16*)(ws + WS_S5CP), (float*)(ws + WS_S5AT), (int)blockIdx.x - QKV_WGS, 256 - QKV_WGS);
            convert_weights(F, args.in, ws, CVT_P0, CVT_ITEMS - CVT_P0 - CVT_GSIDE - cvt_tail, ((int)blockIdx.x - QKV_WGS) * NWAVES + F.wave, (256 - QKV_WGS) * NWAVES);
            convert_panels(F, args.in, ws, 0, NPAN, (int)blockIdx.x - QKV_WGS, 256 - QKV_WGS); }
        if (defer && blockIdx.x >= 128) convert_weights(F, args.in, ws, CVT_NP, CVT_N1, ((int)blockIdx.x - 128) * NWAVES + F.wave, CVT_W1);
        if (BOTH(1)) GRID_BAR(); }
    if (IN(2)) { attn_mfma(F, QKV, args.in[4], args.in[5], AO);
        for (int i = NI8 + (int)blockIdx.x * 512 + F.tid; i < NUP; i += F.G * 512) ((float*)(ws + WS_WSC0))[i] = 1.0f;
        if (BOTH(2)) GRID_BAR(); }
    if (IN(3)) { pg8::Gemm g{AO, (const bf16*)(ws + WS_WO), M, DM, DM, LDX, LDW}; pg8::StaticOrder S; S.init(M, DM, F.G, (int)blockIdx.x);
        pg8::EpiRes<false, false> E{XN, LDX, XN, LDX, SS1, nullptr, XNB};
        pg8::gemm_phase<pg8::EpiRes<false, false>, pg8::StaticOrder, true, true>(F.lds + RING_OFF, g, S, E);
        if (BOTH(3)) GRID_BAR(); }
    if (IN(4)) { quant_rows<true>(F, XN, 0, M, LDX, ws + WS_XQ, (float*)(ws + WS_ASC), SS1, F.vcu * NWAVES + F.wave, F.G * NWAVES); GRID_BAR();
        { pg8::Gemm g{(const bf16*)(ws + WS_XQ), (const bf16*)(ws + WS_WQ0), M, NI8, DM / 2, LDQ / 2, LDQ / 2}; pg8::StaticOrder S; S.init(M, NI8, F.G, (int)blockIdx.x);
          pg8::EpiConvGate E{ACT, LDACT, HEAD, TAIL, args.in[18], args.in[19], FF, NUP, pg8::RowScale{nullptr, (const float*)(ws + WS_ASC), 0.f, 0.f}, TLX, (const float*)(ws + WS_WSC0)};
          pg8::gemm_phase_i8<pg8::EpiConvGate, pg8::StaticOrder, true, true>(F.lds + RING_OFF, g, S, E); }
        __syncthreads();
        int tz; asm volatile("s_mov_b32 %0, 0" : "=s"(tz));
        { pg8::Gemm g{XNB, (const bf16*)(ws + WS_WUP0) + (size_t)NI8 * LDW, M, NUP - NI8, DM, LDX, LDW}; pg8::StaticOrder S; S.init(M, NUP - NI8, F.G, (int)blockIdx.x);
          pg8::EpiConvGate E{ACT + NI8 / 2, LDACT, HEAD + NI8, TAIL + NI8, args.in[18] + NI8 / 2, args.in[19] + NI8 / 2, FF, NUP, pg8::RowScale{SS1, nullptr, INVD, EPS}, TLX, nullptr};
          pg8::gemm_phase<pg8::EpiConvGate, pg8::StaticOrder, true, true>(F.lds + RING_OFF, g, S, E, tz); }
        if (split && blockIdx.x >= 192) { __syncthreads(); convert_weights(F, args.in, ws, CVT_ITEMS - CVT_T4 - CVT_T9, CVT_T4, ((int)blockIdx.x - 192) * NWAVES + F.wave, 64 * NWAVES); }
        if (BOTH(4)) GRID_BAR(); }
    if (IN(5)) { conv_fixup(F, HEAD, TAIL, args.in[18], args.in[19], ACT, (const float*)(ws + WS_WSC0));
        if (BOTH(5)) GRID_BAR(); }
    if (IN(6)) { pg8::Gemm g{ACT, (const bf16*)(ws + WS_WDN0), M, DM, FF, LDACT, LDWF}; pg8::StaticOrder S; S.init(M, DM, F.G, (int)blockIdx.x);
        pg8::EpiRes<false, false> E{XN, LDX, XN, LDX, SS2, (bf16*)(ws + WS_S5H), nullptr};
        pg8::gemm_phase<pg8::EpiRes<false, false>, pg8::StaticOrder, true, true>(F.lds + RING_OFF, g, S, E);
        if (BOTH(6)) GRID_BAR(); }
    if (IN(7)) { s5_mixer(F, SS2, args.in[6], (const bf16*)(ws + WS_S5H), (const bf16*)(ws + WS_S5KT), (const bf16*)(ws + WS_S5BE), (const bf16*)(ws + WS_S5CP), (const float*)(ws + WS_S5AT), args.in[14], AO);
        if (BOTH(7)) GRID_BAR(); }
    if (IN(8)) { pg8::Gemm g{AO, (const bf16*)(ws + WS_WGLU), M, 2 * DM, DM, LDX, LDW}; pg8::StaticOrder S; S.init(M, 2 * DM, F.G, (int)blockIdx.x);
        pg8::EpiGluRes E{XN, LDX, SS3};
        pg8::gemm_phase<pg8::EpiGluRes, pg8::StaticOrder, true, true>(F.lds + RING_OFF, g, S, E);
        if (BOTH(8)) GRID_BAR(); }
    if (IN(9)) { quant_rows<true>(F, XN, 0, M, LDX, ws + WS_XQ, (float*)(ws + WS_ASC), SS3, F.vcu * NWAVES + F.wave, F.G * NWAVES); GRID_BAR();
        pg8::Gemm g{(const bf16*)(ws + WS_XQ), (const bf16*)(ws + WS_WQ1), M, NUP, DM / 2, LDQ / 2, LDQ / 2}; pg8::StaticOrder S; S.init(M, NUP, F.G, (int)blockIdx.x);
        pg8::EpiConvGate E{ACT, LDACT, HEAD, TAIL, args.in[18] + 3 * NUP, args.in[19] + NUP, FF, NUP, pg8::RowScale{nullptr, (const float*)(ws + WS_ASC), 0.f, 0.f}, TLX, (const float*)(ws + WS_WSC1)};
        pg8::gemm_phase_i8<pg8::EpiConvGate, pg8::StaticOrder, true, true>(F.lds + RING_OFF, g, S, E);
        if (split && blockIdx.x >= 192) { __syncthreads(); convert_weights(F, args.in, ws, CVT_ITEMS - CVT_T9, CVT_T9, ((int)blockIdx.x - 192) * NWAVES + F.wave, 64 * NWAVES); }
        if (BOTH(9)) GRID_BAR(); }
    if (IN(10)) { conv_fixup(F, HEAD, TAIL, args.in[18] + 3 * NUP, args.in[19] + NUP, ACT, (const float*)(ws + WS_WSC1)); if (BOTH(10)) GRID_BAR(); }
    if (IN(11)) { pg8::Gemm g{ACT, (const bf16*)(ws + WS_WDN1), M, DM, FF, LDACT, LDWF}; pg8::StaticOrder S; S.init(M, DM, F.G, (int)blockIdx.x);
        pg8::EpiRes<false, false> E{XN, LDX, XN, LDX, SS4, nullptr, nullptr};
        pg8::gemm_phase<pg8::EpiRes<false, false>, pg8::StaticOrder, true, true>(F.lds + RING_OFF, g, S, E);
        if (BOTH(11)) GRID_BAR(); }
    if (IN(12)) { final_rows(F, XN, SS4, args.in[21], args.out); }
#undef IN
#undef BOTH
}

extern "C" void kernel_launch(void* const* d_in, const int* in_sizes, int n_in, void* d_out, int out_size, void* d_ws, size_t ws_size, hipStream_t stream) {
    static int grid = 0;
    if (grid == 0) {
        if (n_in != 22 || out_size != M * DM || ws_size < WS_END) { fprintf(stderr, "kernel_launch: unexpected shapes (n_in %d, out %d, ws %zu < %zu)\n", n_in, out_size, ws_size, (size_t)WS_END); grid = -1; return; }
        int dev = 0, cus = 0, per_cu = 0;
        if (hipGetDevice(&dev) != hipSuccess || hipDeviceGetAttribute(&cus, hipDeviceAttributeMultiprocessorCount, dev) != hipSuccess) { grid = -1; return; }
        if (hipFuncSetAttribute((const void*)mk_fwd, hipFuncAttributeMaxDynamicSharedMemorySize, LDS_BYTES) != hipSuccess) { fprintf(stderr, "kernel_launch: hipFuncSetAttribute failed\n"); grid = -1; return; }
        if (hipOccupancyMaxActiveBlocksPerMultiprocessor(&per_cu, (const void*)mk_fwd, NWAVES * 64, LDS_BYTES) != hipSuccess || per_cu < 1) { fprintf(stderr, "kernel_launch: occupancy query reports %d\n", per_cu); }
        (void)hipGetLastError();
        grid = cus;
    }
    if (grid < 0) return;
    if (hipMemsetAsync((char*)d_ws + WS_CTL, 0, CTL_ZERO_BYTES, stream) != hipSuccess) return;
    Args a{};
    for (int i = 0; i < 22; ++i) a.in[i] = (const float*)d_in[i];
    a.out = (float*)d_out; a.ws = (unsigned char*)d_ws;
    for (int li = 0; li < N_LAUNCHES; ++li) {
        if (N_LAUNCHES == 1) { a.ph_lo = 0; a.ph_hi = N_PHASES; } else { a.ph_lo = li; a.ph_hi = li + 1; }
        a.li = li; a.pad = 0;
        hipLaunchKernelGGL(mk_fwd, dim3(grid), dim3(NWAVES * 64), LDS_BYTES, stream, a);
    }
}
```

```cpp
#include <hip/hip_runtime.h>
#include <cstdio>
#include <cstdint>
namespace pg8 {
#define PG8_LAS __attribute__((address_space(3)))
typedef unsigned short bf16_t;
typedef short bf16x8 __attribute__((ext_vector_type(8)));
typedef float f32x4 __attribute__((ext_vector_type(4)));
typedef int i32x4 __attribute__((ext_vector_type(4)));
typedef unsigned u32x4 __attribute__((ext_vector_type(4)));
constexpr int BM = 256, BK = 64, HALF = 128, HTB = HALF * BK * 2  , STAGE_BYTES = 8 * HTB, NXCD = 8, WGM = 8;

__host__ __device__ __forceinline__ int lds_byte(int r, int c) { const int st = (r >> 4) * 2 + (c >> 5), rr = r & 15, cc = c & 31, ob = rr * 64 + cc * 2; return st * 1024 + (ob ^ (((ob >> 9) & 1) << 5)); }
__host__ __device__ __forceinline__ void stage_rc(int b, int& R, int& C) { const int st = b / 1024, sb = b % 1024, swz = sb ^ (((sb >> 9) & 1) << 5); R = (st >> 1) * 16 + swz / 64; C = (st & 1) * 32 + (swz % 64) / 2; }
__host__ __device__ __forceinline__ int perm32(int rho) { const int n = rho >> 4, i = rho & 15; return 8 * (i >> 2) + 4 * n + (i & 3); }

struct Unit { int pm, pn; };
struct Gemm { const bf16_t* A; const bf16_t* Bt; int M, N, K, lda, ldb; };

struct StaticOrder {
    int nM, nN, nwg, G, c;
    __host__ __device__ void init(int M, int N, int G_, int c_) { nM = M / BM; nN = N / BM; nwg = nM * nN; G = G_; c = c_; }
    __host__ __device__ bool next(int i, Unit& u) const {
        const long L = (long)i * G + c; if (L >= nwg) return false;
        int wgid = (int)L; { const int q = nwg / NXCD, r = nwg % NXCD, xcd = wgid % NXCD, off = wgid / NXCD; wgid = (xcd < r ? xcd * (q + 1) : r * (q + 1) + (xcd - r) * q) + off; }
        const int nig = WGM * nN, gid = wgid / nig, fm = gid * WGM, gsz = (nM - fm) < WGM ? (nM - fm) : WGM;
        u.pm = fm + ((wgid % nig) % gsz); u.pn = (wgid % nig) / gsz; return true;
    }
    __device__ __forceinline__ void a_ready(const Unit&) const {}
    __device__ __forceinline__ void done(const Unit&) const {}
};

__device__ __forceinline__ unsigned cvt_pk_bf16(float lo, float hi) { unsigned r; asm volatile("v_cvt_pk_bf16_f32 %0, %1, %2" : "=v"(r) : "v"(lo), "v"(hi)); return r; }
typedef unsigned u32x2 __attribute__((ext_vector_type(2)));
__device__ __forceinline__ float fast_sigmoid(float x) { return __builtin_amdgcn_rcpf(1.0f + __builtin_amdgcn_exp2f(-1.4426950408889634f * x)); }

struct EpiBf16 {
    static constexpr bool PERM = true, AFTER_DRAIN = false;
    bf16_t* O; int ldc;
    __device__ __forceinline__ void operator()(const f32x4 (&acc)[2][2][4][2], const Unit& u, int wr, int wc, int fr, int fq) const {
        const int row0 = u.pm * BM + wr * 64 + fr; const int col0 = u.pn * BM + wc * 32 + 8 * fq;
#pragma unroll
        for (int ai = 0; ai < 2; ++ai)
#pragma unroll
            for (int m = 0; m < 4; ++m) { bf16_t* rowp = O + (size_t)(row0 + ai * HALF + m * 16) * ldc + col0;
#pragma unroll
                for (int bj = 0; bj < 2; ++bj) { const f32x4 v0 = acc[ai][bj][m][0], v1 = acc[ai][bj][m][1];
                    u32x4 w; w.x = cvt_pk_bf16(v0[0], v0[1]); w.y = cvt_pk_bf16(v0[2], v0[3]); w.z = cvt_pk_bf16(v1[0], v1[1]); w.w = cvt_pk_bf16(v1[2], v1[3]);
                    *(u32x4*)(rowp + bj * HALF) = w; } }
    }
};
typedef _Float16 xh2 __attribute__((ext_vector_type(2))); typedef float xf2 __attribute__((ext_vector_type(2)));
__device__ __forceinline__ unsigned xpk(float lo, float hi) { const xf2 v = {lo, hi}; const xh2 h = __builtin_convertvector(v, xh2); return __builtin_bit_cast(unsigned, h); }
__device__ __forceinline__ float xlo(unsigned w) { const xh2 h = __builtin_bit_cast(xh2, w); return (float)h.x; }
__device__ __forceinline__ float xhi(unsigned w) { const xh2 h = __builtin_bit_cast(xh2, w); return (float)h.y; }
__device__ __forceinline__ float bflo(unsigned w) { return __uint_as_float(w << 16); }
__device__ __forceinline__ float bfhi(unsigned w) { return __uint_as_float(w & 0xffff0000u); }
typedef unsigned ssq_t;
constexpr float SSQ_SCALE = 1024.0f;
__device__ __forceinline__ float ss_get(const ssq_t* ss, int row) { return (float)ss[row] * (1.0f / SSQ_SCALE); }
__device__ __forceinline__ ssq_t ss_fix(float v) { return __float2uint_rn(v * SSQ_SCALE); }
struct RowScale { const ssq_t* ss; const float* dir; float invd, eps;
    __device__ __forceinline__ float operator()(int row) const { return dir ? dir[row] : __builtin_amdgcn_rsqf(ss_get(ss, row) * invd + eps); } };
__device__ __forceinline__ void ss_add(ssq_t* ss, int row, float v, int fq) { v += __shfl_xor(v, 16); v += __shfl_xor(v, 32); if (fq == 0) atomicAdd(ss + row, ss_fix(v)); }

struct EpiBf16Scale {
    static constexpr bool PERM = true, AFTER_DRAIN = false;
    bf16_t* O; int ldc; RowScale rs;
    __device__ __forceinline__ void operator()(const f32x4 (&acc)[2][2][4][2], const Unit& u, int wr, int wc, int fr, int fq) const {
        const int row0 = u.pm * BM + wr * 64 + fr; const int col0 = u.pn * BM + wc * 32 + 8 * fq;
        float rsc[2][4];
#pragma unroll
        for (int ai = 0; ai < 2; ++ai)
#pragma unroll
            for (int m = 0; m < 4; ++m) rsc[ai][m] = rs(row0 + ai * HALF + m * 16);
#pragma unroll
        for (int ai = 0; ai < 2; ++ai)
#pragma unroll
            for (int m = 0; m < 4; ++m) { const int row = row0 + ai * HALF + m * 16; const float r = rsc[ai][m]; bf16_t* rowp = O + (size_t)row * ldc + col0;
#pragma unroll
                for (int bj = 0; bj < 2; ++bj) { const f32x4 v0 = acc[ai][bj][m][0] * r, v1 = acc[ai][bj][m][1] * r;
                    u32x4 w; w.x = cvt_pk_bf16(v0[0], v0[1]); w.y = cvt_pk_bf16(v0[2], v0[3]); w.z = cvt_pk_bf16(v1[0], v1[1]); w.w = cvt_pk_bf16(v1[2], v1[3]);
                    *(u32x4*)(rowp + bj * HALF) = w; } }
    }
};
template <bool BASE_F32, bool OUT_F32> struct EpiRes {
    static constexpr bool PERM = true, AFTER_DRAIN = false;
    const void* base; int ldb; void* out; int ldo; ssq_t* ss;
    bf16_t* slab;
    bf16_t* bcopy;
    __device__ __forceinline__ void operator()(const f32x4 (&acc)[2][2][4][2], const Unit& u, int wr, int wc, int fr, int fq) const {
        int row0 = u.pm * BM + wr * 64 + fr; int col0 = u.pn * BM + wc * 32 + 8 * fq;
        asm volatile("" : "+v"(row0), "+v"(col0));
#pragma unroll
        for (int ai = 0; ai < 2; ++ai) {
            f32x4 b[4][2][2];
#pragma unroll
            for (int m = 0; m < 4; ++m) { const int row = row0 + ai * HALF + m * 16;
#pragma unroll
                for (int bj = 0; bj < 2; ++bj) {
                    if (BASE_F32) { const float* p = (const float*)base + (size_t)row * ldb + col0 + bj * HALF; b[m][bj][0] = *(const f32x4*)p; b[m][bj][1] = *(const f32x4*)(p + 4); }
                    else { const u32x4 w = *(const u32x4*)((const bf16_t*)base + (size_t)row * ldb + col0 + bj * HALF);
                        b[m][bj][0] = (f32x4){xlo(w.x), xhi(w.x), xlo(w.y), xhi(w.y)}; b[m][bj][1] = (f32x4){xlo(w.z), xhi(w.z), xlo(w.w), xhi(w.w)}; } } }
            asm volatile("" ::: "memory");
#pragma unroll
            for (int m = 0; m < 4; ++m) { const int row = row0 + ai * HALF + m * 16; float sq = 0.f;
#pragma unroll
                for (int bj = 0; bj < 2; ++bj) { const f32x4 v0 = b[m][bj][0] + acc[ai][bj][m][0], v1 = b[m][bj][1] + acc[ai][bj][m][1];
                    if (OUT_F32) { float* p = (float*)out + (size_t)row * ldo + col0 + bj * HALF; *(f32x4*)p = v0; *(f32x4*)(p + 4) = v1;
                        sq += (v0[0] * v0[0] + v0[1] * v0[1]) + (v0[2] * v0[2] + v0[3] * v0[3]) + (v1[0] * v1[0] + v1[1] * v1[1]) + (v1[2] * v1[2] + v1[3] * v1[3]); }
                    else { u32x4 w; w.x = xpk(v0[0], v0[1]); w.y = xpk(v0[2], v0[3]); w.z = xpk(v1[0], v1[1]); w.w = xpk(v1[2], v1[3]);
                        *(u32x4*)((bf16_t*)out + (size_t)row * ldo + col0 + bj * HALF) = w;
                        if (bcopy) { u32x4 wb; wb.x = cvt_pk_bf16(v0[0], v0[1]); wb.y = cvt_pk_bf16(v0[2], v0[3]); wb.z = cvt_pk_bf16(v1[0], v1[1]); wb.w = cvt_pk_bf16(v1[2], v1[3]); *(u32x4*)(bcopy + (size_t)row * ldo + col0 + bj * HALF) = wb; }
                        if (slab) { const int col = col0 + bj * HALF; *(u32x4*)(slab + ((size_t)(((row >> 12) * 256 + (col >> 4)) * 4096 + (row & 4095))) * 16 + (col & 8)) = w; }
                        const float a0 = xlo(w.x), a1 = xhi(w.x), a2 = xlo(w.y), a3 = xhi(w.y), a4 = xlo(w.z), a5 = xhi(w.z), a6 = xlo(w.w), a7 = xhi(w.w);
                        sq += (a0 * a0 + a1 * a1) + (a2 * a2 + a3 * a3) + (a4 * a4 + a5 * a5) + (a6 * a6 + a7 * a7); } }
                ss_add(ss, row, sq, fq); }
            asm volatile("" ::: "memory");
        }
    }
};
struct EpiGluRes {
    static constexpr bool PERM = true, AFTER_DRAIN = false;
    bf16_t* X; int ldx; ssq_t* ss;
    __device__ __forceinline__ void operator()(const f32x4 (&acc)[2][2][4][2], const Unit& u, int wr, int wc, int fr, int fq) const {
        const int row0 = u.pm * BM + wr * 64 + fr, col0 = u.pn * HALF + wc * 32 + 8 * fq;
        u32x4 b[2][4];
#pragma unroll
        for (int ai = 0; ai < 2; ++ai)
#pragma unroll
            for (int m = 0; m < 4; ++m) b[ai][m] = *(const u32x4*)(X + (size_t)(row0 + ai * HALF + m * 16) * ldx + col0);
        asm volatile("" ::: "memory");
#pragma unroll
        for (int ai = 0; ai < 2; ++ai)
#pragma unroll
            for (int m = 0; m < 4; ++m) { const int row = row0 + ai * HALF + m * 16; const u32x4 w0 = b[ai][m];
                const f32x4 a0 = acc[ai][0][m][0], g0 = acc[ai][1][m][0], a1 = acc[ai][0][m][1], g1 = acc[ai][1][m][1];
                const float o0 = xlo(w0.x) + a0[0] * fast_sigmoid(g0[0]), o1 = xhi(w0.x) + a0[1] * fast_sigmoid(g0[1]), o2 = xlo(w0.y) + a0[2] * fast_sigmoid(g0[2]), o3 = xhi(w0.y) + a0[3] * fast_sigmoid(g0[3]);
                const float o4 = xlo(w0.z) + a1[0] * fast_sigmoid(g1[0]), o5 = xhi(w0.z) + a1[1] * fast_sigmoid(g1[1]), o6 = xlo(w0.w) + a1[2] * fast_sigmoid(g1[2]), o7 = xhi(w0.w) + a1[3] * fast_sigmoid(g1[3]);
                u32x4 w; w.x = xpk(o0, o1); w.y = xpk(o2, o3); w.z = xpk(o4, o5); w.w = xpk(o6, o7);
                *(u32x4*)(X + (size_t)row * ldx + col0) = w;
                const float q0 = xlo(w.x), q1 = xhi(w.x), q2 = xlo(w.y), q3 = xhi(w.y), q4 = xlo(w.z), q5 = xhi(w.z), q6 = xlo(w.w), q7 = xhi(w.w);
                ss_add(ss, row, (q0 * q0 + q1 * q1) + (q2 * q2 + q3 * q3) + (q4 * q4 + q5 * q5) + (q6 * q6 + q7 * q7), fq); }
    }
};
struct EpiConvGate {
    static constexpr bool PERM = true, AFTER_DRAIN = false;
    bf16_t* ACT; int ldc;
    float* HEAD; float* TAIL;
    const float* cw; const float* cb; int FF, NUP;
    RowScale rs;
    PG8_LAS float* tl;
    const float* wsc;
    __device__ __forceinline__ void operator()(const f32x4 (&acc)[2][2][4][2], const Unit& u, int wr, int wc, int fr, int fq) const {
        asm volatile("" : "+v"(fr), "+v"(fq));
        float rsc[2][4];
#pragma unroll
        for (int ai = 0; ai < 2; ++ai)
#pragma unroll
            for (int m = 0; m < 4; ++m) rsc[ai][m] = rs(u.pm * BM + ai * HALF + wr * 64 + m * 16 + fr);
        const int lcol = wc * 32 + 8 * fq;
        if (fr >= 14) {
#pragma unroll
            for (int ai = 0; ai < 2; ++ai)
#pragma unroll
                for (int bj = 0; bj < 2; ++bj)
#pragma unroll
                    for (int n = 0; n < 2; ++n) *(PG8_LAS f32x4*)(tl + ((2 * ai + wr) * 2 + (fr - 14)) * 256 + bj * HALF + lcol + 4 * n) = acc[ai][bj][3][n] * rsc[ai][3];
        }
        asm volatile("s_waitcnt lgkmcnt(0)" ::: "memory"); __builtin_amdgcn_s_barrier(); asm volatile("" ::: "memory");
#pragma unroll
        for (int n = 0; n < 2; ++n) {
            const int f0 = u.pn * HALF + lcol + 4 * n;
            const int nn = u.pn * BM + lcol + 4 * n;
            f32x4 w0[2], w1[2], w2[2], bb[2];
#pragma unroll
            for (int bj = 0; bj < 2; ++bj) { const float* p = cw + bj * FF + f0; w0[bj] = *(const f32x4*)p; w1[bj] = *(const f32x4*)(p + NUP); w2[bj] = *(const f32x4*)(p + 2 * NUP); bb[bj] = *(const f32x4*)(cb + bj * FF + f0); }
            if (wsc) {
#pragma unroll
                for (int bj = 0; bj < 2; ++bj) { const f32x4 sc = *(const f32x4*)(wsc + nn + bj * HALF); w0[bj] = w0[bj] * sc; w1[bj] = w1[bj] * sc; w2[bj] = w2[bj] * sc; } }
#pragma unroll
            for (int ai = 0; ai < 2; ++ai) {
                const int blkl = 2 * ai + wr;
                if (blkl == 0 && fr < 2) { float* hp = HEAD + (unsigned)((u.pm * 2 + fr) * NUP + nn); *(f32x4*)hp = acc[0][0][0][n] * rsc[0][0]; *(f32x4*)(hp + HALF) = acc[0][1][0][n] * rsc[0][0]; }
                if (blkl == 3 && fr >= 14) { float* tp = TAIL + (unsigned)((u.pm * 2 + (fr - 14)) * NUP + nn); *(f32x4*)tp = acc[1][0][3][n] * rsc[1][3]; *(f32x4*)(tp + HALF) = acc[1][1][3][n] * rsc[1][3]; }
                f32x4 tlv[2];
#pragma unroll
                for (int bj = 0; bj < 2; ++bj) tlv[bj] = *(const PG8_LAS f32x4*)(tl + ((blkl > 0 ? blkl - 1 : 0) * 2 + (fr & 1)) * 256 + bj * HALF + lcol + 4 * n);
#pragma unroll
                for (int m = 0; m < 4; ++m) {
                    f32x4 c[2];
#pragma unroll
                    for (int bj = 0; bj < 2; ++bj) {
                        const f32x4 cur = acc[ai][bj][m][n] * rsc[ai][m], prv = m > 0 ? acc[ai][bj][m > 0 ? m - 1 : 0][n] * rsc[ai][m > 0 ? m - 1 : 0] : tlv[bj];
                        f32x4 u1, u2;
#pragma unroll
                        for (int j = 0; j < 4; ++j) {
                            const float cf = cur[j], pf = prv[j]; const int ci = __float_as_int(cf), pi = __float_as_int(pf);
                            const int p1 = __builtin_amdgcn_update_dpp(0, pi, 0x10F, 0xf, 0xf, true);
                            const int p2 = __builtin_amdgcn_update_dpp(0, pi, 0x10E, 0xf, 0xf, true);
                            u1[j] = __int_as_float(__builtin_amdgcn_update_dpp(p1, ci, 0x111, 0xf, 0xf, false));
                            u2[j] = __int_as_float(__builtin_amdgcn_update_dpp(p2, ci, 0x112, 0xf, 0xf, false));
                        }
                        c[bj] = bb[bj] + w0[bj] * u2 + w1[bj] * u1 + w2[bj] * cur;
                    }
                    f32x4 o;
#pragma unroll
                    for (int j = 0; j < 4; ++j) o[j] = c[0][j] * fast_sigmoid(c[0][j]) * c[1][j];
                    u32x2 w; w.x = cvt_pk_bf16(o[0], o[1]); w.y = cvt_pk_bf16(o[2], o[3]);
                    { bf16_t* ap = ACT + (size_t)(u.pm * BM + ai * HALF + wr * 64 + m * 16 + fr) * ldc + f0;
                      asm volatile("global_store_dwordx2 %0, %1, off sc0 sc1" :: "v"(ap), "v"(w) : "memory"); }
                }
            }
        }
    }
};

typedef _Float16 f16x8 __attribute__((ext_vector_type(8)));
template <bool F16> __device__ __forceinline__ f32x4 mma16(const bf16x8 b, const bf16x8 a, const f32x4 c) {
    if constexpr (F16) return __builtin_amdgcn_mfma_f32_16x16x32_f16(__builtin_bit_cast(f16x8, b), __builtin_bit_cast(f16x8, a), c, 0, 0, 0);
    else return __builtin_amdgcn_mfma_f32_16x16x32_bf16(b, a, c, 0, 0, 0);
}
template <class Epi, class Sched, bool ALIGN_EPI = false, bool SP2 = false, bool F16 = false>
__device__ __forceinline__ void gemm_phase(PG8_LAS unsigned char* lds, const Gemm g, const Sched& S, const Epi& E, const int tz = 0) {
    const int tid = threadIdx.x + tz, wid = __builtin_amdgcn_readfirstlane(tid >> 6), lane = tid & 63, wr = wid >> 2, wc = wid & 3, fr = lane & 15, fq = lane >> 4;
    const int K = g.K, nt = K / BK;
    unsigned voffA[2], voffB[2];
#pragma unroll
    for (int i = 0; i < 2; ++i) { int R, C; stage_rc(tid * 16 + i * 8192, R, C); const int Rb = Epi::PERM ? ((R & ~31) + perm32(R & 31)) : R;
        voffA[i] = (unsigned)(R * g.lda + C) * 2u; voffB[i] = (unsigned)(Rb * g.ldb + C) * 2u; }
    const size_t kstep = (size_t)(BK * 2);
    const size_t hstepA = (size_t)HALF * g.lda * 2, hstepB = (size_t)HALF * g.ldb * 2;
    const size_t tstepA = 2 * hstepA, tstepB = 2 * hstepB;
    const unsigned ldsw = (unsigned)wid * 1024u;
    const int aoff = lds_byte(wr * 64 + fr, fq * 8), boff = lds_byte(wc * 32 + fr, fq * 8);
#define PG8_SA(b, h) (((b) * 2 + (h)) * HTB)
#define PG8_SB(b, h) ((4 + (b) * 2 + (h)) * HTB)
#define PG8_STAGE(bufoff, gbase, voff) do { _Pragma("unroll") for (int _i = 0; _i < 2; ++_i) \
        __builtin_amdgcn_global_load_lds((const unsigned*)((const char*)(gbase) + (voff)[_i]), (PG8_LAS unsigned*)(lds + (bufoff) + ldsw + _i * 8192), 16, 0, 0); } while (0)
#define PG8_LDA(dst, b, h) do { _Pragma("unroll") for (int m = 0; m < 4; ++m) _Pragma("unroll") for (int k = 0; k < 2; ++k) dst[m][k] = *(const PG8_LAS bf16x8*)(lds + PG8_SA(b, h) + aoff + m * 2048 + k * 1024); } while (0)
#define PG8_LDB(dst, b, h) do { _Pragma("unroll") for (int n = 0; n < 2; ++n) _Pragma("unroll") for (int k = 0; k < 2; ++k) dst[n][k] = *(const PG8_LAS bf16x8*)(lds + PG8_SB(b, h) + boff + n * 2048 + k * 1024); } while (0)
#define PG8_MMA(ai, bj, At, Bt) do { __builtin_amdgcn_s_setprio(1); _Pragma("unroll") for (int m = 0; m < 4; ++m) _Pragma("unroll") for (int n = 0; n < 2; ++n) _Pragma("unroll") for (int k = 0; k < 2; ++k) \
        acc[ai][bj][m][n] = mma16<F16>(Bt[n][k], At[m][k], acc[ai][bj][m][n]); __builtin_amdgcn_s_setprio(0); } while (0)
#define PG8_WAIT_V(n) asm volatile("s_waitcnt vmcnt(" #n ")" ::: "memory")
#define PG8_WAIT_L(n) asm volatile("s_waitcnt lgkmcnt(" #n ")" ::: "memory")
#define PG8_BAR __builtin_amdgcn_s_barrier()
#define PG8_SCHED __builtin_amdgcn_sched_barrier(0)
    Unit cur, nxt; int ui = 0;
    if (!S.next(0, cur)) return;
    f32x4 acc[2][2][4][2];
#pragma unroll
    for (int a = 0; a < 2; ++a)
#pragma unroll
        for (int b = 0; b < 2; ++b)
#pragma unroll
            for (int m = 0; m < 4; ++m)
#pragma unroll
                for (int n = 0; n < 2; ++n) acc[a][b][m][n] = (f32x4){0.f, 0.f, 0.f, 0.f};
    bf16x8 At[4][2], B0[2][2], B1[2][2];
    const char* cA = (const char*)g.A + (size_t)cur.pm * tstepA; const char* cB = (const char*)g.Bt + (size_t)cur.pn * tstepB;
    S.a_ready(cur);
    if constexpr (SP2) {
        PG8_STAGE(PG8_SB(0, 0), cB, voffB); PG8_STAGE(PG8_SB(0, 1), cB + hstepB, voffB); PG8_STAGE(PG8_SA(0, 0), cA, voffA); PG8_STAGE(PG8_SA(0, 1), cA + hstepA, voffA);
        if (wr == 1) PG8_BAR;
        PG8_WAIT_V(2); PG8_BAR;
        PG8_STAGE(PG8_SB(1, 0), cB + kstep, voffB); PG8_STAGE(PG8_SA(1, 0), cA + kstep, voffA); PG8_STAGE(PG8_SB(1, 1), cB + hstepB + kstep, voffB);
        PG8_WAIT_V(6); PG8_BAR;
    } else {
        PG8_STAGE(PG8_SB(0, 0), cB, voffB); PG8_STAGE(PG8_SA(0, 0), cA, voffA); PG8_STAGE(PG8_SB(0, 1), cB + hstepB, voffB); PG8_STAGE(PG8_SA(0, 1), cA + hstepA, voffA);
        if (wr == 1) PG8_BAR;
        PG8_WAIT_V(4); PG8_BAR;
        PG8_STAGE(PG8_SB(1, 0), cB + kstep, voffB); PG8_STAGE(PG8_SA(1, 0), cA + kstep, voffA); PG8_STAGE(PG8_SB(1, 1), cB + hstepB + kstep, voffB);
        PG8_WAIT_V(6); PG8_BAR;
    }
    for (;;) {
        const bool has_next = S.next(ui + 1, nxt);
        const char* nA = has_next ? (const char*)g.A + (size_t)nxt.pm * tstepA : cA; const char* nB = has_next ? (const char*)g.Bt + (size_t)nxt.pn * tstepB : cB;
        for (int t = 0; t < nt; t += 2) {
            const bool last = (t == nt - 2);
            const char* a1 = cA + (size_t)(t + 1) * kstep;
            const char* a2 = last ? nA : cA + (size_t)(t + 2) * kstep; const char* b2 = last ? nB : cB + (size_t)(t + 2) * kstep;
            const char* a3 = a2 + kstep; const char* b3 = b2 + kstep;
            if (last && has_next) S.a_ready(nxt);
            if constexpr (SP2) {
            PG8_LDB(B0, 0, 0); PG8_LDB(B1, 0, 1); PG8_SCHED; PG8_LDA(At, 0, 0); PG8_STAGE(PG8_SA(1, 1), a1 + hstepA, voffA);
            PG8_WAIT_V(8); PG8_WAIT_L(0); PG8_BAR; PG8_MMA(0, 0, At, B0); PG8_MMA(0, 1, At, B1); PG8_BAR; PG8_SCHED;
            PG8_LDA(At, 0, 1); PG8_STAGE(PG8_SB(0, 0), b2, voffB); PG8_STAGE(PG8_SB(0, 1), b2 + hstepB, voffB); PG8_STAGE(PG8_SA(0, 0), a2, voffA);
            PG8_WAIT_V(8); PG8_WAIT_L(0); PG8_BAR; PG8_MMA(1, 0, At, B0); PG8_MMA(1, 1, At, B1); PG8_BAR; PG8_SCHED;
            PG8_LDB(B0, 1, 0); PG8_LDB(B1, 1, 1); PG8_SCHED; PG8_LDA(At, 1, 0); PG8_STAGE(PG8_SA(0, 1), a2 + hstepA, voffA);
            PG8_WAIT_V(8); PG8_WAIT_L(0); PG8_BAR; PG8_MMA(0, 0, At, B0); PG8_MMA(0, 1, At, B1); PG8_BAR; PG8_SCHED;
            PG8_LDA(At, 1, 1); PG8_STAGE(PG8_SB(1, 0), b3, voffB); PG8_STAGE(PG8_SB(1, 1), b3 + hstepB, voffB); PG8_STAGE(PG8_SA(1, 0), a3, voffA);
            PG8_WAIT_V(8); PG8_WAIT_L(0); PG8_BAR; PG8_MMA(1, 0, At, B0); PG8_MMA(1, 1, At, B1); PG8_BAR; PG8_SCHED;
            } else {
            PG8_LDB(B0, 0, 0); PG8_SCHED; PG8_LDA(At, 0, 0); PG8_STAGE(PG8_SA(1, 1), a1 + hstepA, voffA);
            PG8_WAIT_L(8); PG8_BAR; PG8_WAIT_L(0); PG8_MMA(0, 0, At, B0); PG8_BAR; PG8_SCHED;
            PG8_LDB(B1, 0, 1); PG8_STAGE(PG8_SB(0, 0), b2, voffB);
            PG8_BAR; PG8_WAIT_L(0); PG8_MMA(0, 1, At, B1); PG8_BAR;
            PG8_LDA(At, 0, 1); PG8_STAGE(PG8_SA(0, 0), a2, voffA);
            PG8_BAR; PG8_WAIT_L(0); PG8_MMA(1, 0, At, B0); PG8_BAR; PG8_SCHED;
            PG8_STAGE(PG8_SB(0, 1), b2 + hstepB, voffB);
            PG8_WAIT_V(6); PG8_BAR; PG8_MMA(1, 1, At, B1); PG8_BAR;
            PG8_LDB(B0, 1, 0); PG8_SCHED; PG8_LDA(At, 1, 0); PG8_STAGE(PG8_SA(0, 1), a2 + hstepA, voffA);
            PG8_WAIT_L(8); PG8_BAR; PG8_WAIT_L(0); PG8_MMA(0, 0, At, B0); PG8_BAR; PG8_SCHED;
            PG8_LDB(B1, 1, 1); PG8_STAGE(PG8_SB(1, 0), b3, voffB);
            PG8_BAR; PG8_WAIT_L(0); PG8_MMA(0, 1, At, B1); PG8_BAR;
            PG8_LDA(At, 1, 1); PG8_STAGE(PG8_SA(1, 0), a3, voffA);
            PG8_BAR; PG8_WAIT_L(0); PG8_MMA(1, 0, At, B0); PG8_BAR; PG8_SCHED;
            PG8_STAGE(PG8_SB(1, 1), b3 + hstepB, voffB);
            PG8_WAIT_V(6); PG8_BAR; PG8_MMA(1, 1, At, B1); PG8_BAR;
            }
        }
        if constexpr (ALIGN_EPI) { if (wr == 0) PG8_BAR; }
        if constexpr (!Epi::AFTER_DRAIN) { E(acc, cur, wr, wc, fr, fq); S.done(cur); }
        if (!has_next) break;
#pragma unroll
        for (int a = 0; a < 2; ++a)
#pragma unroll
            for (int b = 0; b < 2; ++b)
#pragma unroll
                for (int m = 0; m < 4; ++m)
#pragma unroll
                    for (int n = 0; n < 2; ++n) acc[a][b][m][n] = (f32x4){0.f, 0.f, 0.f, 0.f};
        cur = nxt; cA = nA; cB = nB; ++ui;
        if constexpr (ALIGN_EPI) { if (wr == 1) PG8_BAR; }
    }
    PG8_WAIT_V(0);
    if constexpr (!ALIGN_EPI) { if (wr == 0) PG8_BAR; }
    PG8_BAR;
    if constexpr (Epi::AFTER_DRAIN) { E.fused(acc, cur, wr, wc, fr, fq, lds, wid, lane); S.done(cur); }
#undef PG8_SA
#undef PG8_SB
#undef PG8_STAGE
#undef PG8_LDA
#undef PG8_LDB
#undef PG8_MMA
#undef PG8_WAIT_V
#undef PG8_WAIT_L
#undef PG8_BAR
#undef PG8_SCHED
}
template <class Epi, class Sched, bool ALIGN_EPI = false, bool SP2 = false>
__device__ __forceinline__ void gemm_phase_i8(PG8_LAS unsigned char* lds, const Gemm g, const Sched& S, const Epi& E) {
    const int tid = threadIdx.x, wid = __builtin_amdgcn_readfirstlane(tid >> 6), lane = tid & 63, wr = wid >> 2, wc = wid & 3, fr = lane & 15, fq = lane >> 4;
    const int K = g.K, nt = K / BK;
    unsigned voffA[2], voffB[2];
#pragma unroll
    for (int i = 0; i < 2; ++i) { int R, C; stage_rc(tid * 16 + i * 8192, R, C); const int Rb = Epi::PERM ? ((R & ~31) + perm32(R & 31)) : R;
        voffA[i] = (unsigned)(R * g.lda + C) * 2u; voffB[i] = (unsigned)(Rb * g.ldb + C) * 2u; }
    const size_t kstep = (size_t)(BK * 2);
    const size_t hstepA = (size_t)HALF * g.lda * 2, hstepB = (size_t)HALF * g.ldb * 2;
    const size_t tstepA = 2 * hstepA, tstepB = 2 * hstepB;
    const unsigned ldsw = (unsigned)wid * 1024u;
    const int aoff = lds_byte(wr * 64 + fr, fq * 8), boff = lds_byte(wc * 32 + fr, fq * 8);
#define PG8_SA(b, h) (((b) * 2 + (h)) * HTB)
#define PG8_SB(b, h) ((4 + (b) * 2 + (h)) * HTB)
#define PG8_STAGE(bufoff, gbase, voff) do { _Pragma("unroll") for (int _i = 0; _i < 2; ++_i) \
        __builtin_amdgcn_global_load_lds((const unsigned*)((const char*)(gbase) + (voff)[_i]), (PG8_LAS unsigned*)(lds + (bufoff) + ldsw + _i * 8192), 16, 0, 0); } while (0)
#define PG8_LDA(dst, b, h) do { _Pragma("unroll") for (int m = 0; m < 4; ++m) _Pragma("unroll") for (int k = 0; k < 2; ++k) dst[m][k] = *(const PG8_LAS bf16x8*)(lds + PG8_SA(b, h) + aoff + m * 2048 + k * 1024); } while (0)
#define PG8_LDB(dst, b, h) do { _Pragma("unroll") for (int n = 0; n < 2; ++n) _Pragma("unroll") for (int k = 0; k < 2; ++k) dst[n][k] = *(const PG8_LAS bf16x8*)(lds + PG8_SB(b, h) + boff + n * 2048 + k * 1024); } while (0)
#define PG8_MMA(ai, bj, At, Bt) do { __builtin_amdgcn_s_setprio(1); _Pragma("unroll") for (int m = 0; m < 4; ++m) _Pragma("unroll") for (int n = 0; n < 2; ++n) _Pragma("unroll") for (int k = 0; k < 2; ++k) \
        acc[ai][bj][m][n] = __builtin_amdgcn_mfma_i32_16x16x64_i8(__builtin_bit_cast(i32x4, Bt[n][k]), __builtin_bit_cast(i32x4, At[m][k]), acc[ai][bj][m][n], 0, 0, 0); __builtin_amdgcn_s_setprio(0); } while (0)
#define PG8_WAIT_V(n) asm volatile("s_waitcnt vmcnt(" #n ")" ::: "memory")
#define PG8_WAIT_L(n) asm volatile("s_waitcnt lgkmcnt(" #n ")" ::: "memory")
#define PG8_BAR __builtin_amdgcn_s_barrier()
#define PG8_SCHED __builtin_amdgcn_sched_barrier(0)
    Unit cur, nxt; int ui = 0;
    if (!S.next(0, cur)) return;
    i32x4 acc[2][2][4][2];
#pragma unroll
    for (int a = 0; a < 2; ++a)
#pragma unroll
        for (int b = 0; b < 2; ++b)
#pragma unroll
            for (int m = 0; m < 4; ++m)
#pragma unroll
                for (int n = 0; n < 2; ++n) acc[a][b][m][n] = (i32x4){0, 0, 0, 0};
    bf16x8 At[4][2], B0[2][2], B1[2][2];
    const char* cA = (const char*)g.A + (size_t)cur.pm * tstepA; const char* cB = (const char*)g.Bt + (size_t)cur.pn * tstepB;
    S.a_ready(cur);
    if constexpr (SP2) {
        PG8_STAGE(PG8_SB(0, 0), cB, voffB); PG8_STAGE(PG8_SB(0, 1), cB + hstepB, voffB); PG8_STAGE(PG8_SA(0, 0), cA, voffA); PG8_STAGE(PG8_SA(0, 1), cA + hstepA, voffA);
        if (wr == 1) PG8_BAR;
        PG8_WAIT_V(2); PG8_BAR;
        PG8_STAGE(PG8_SB(1, 0), cB + kstep, voffB); PG8_STAGE(PG8_SA(1, 0), cA + kstep, voffA); PG8_STAGE(PG8_SB(1, 1), cB + hstepB + kstep, voffB);
        PG8_WAIT_V(6); PG8_BAR;
    } else {
        PG8_STAGE(PG8_SB(0, 0), cB, voffB); PG8_STAGE(PG8_SA(0, 0), cA, voffA); PG8_STAGE(PG8_SB(0, 1), cB + hstepB, voffB); PG8_STAGE(PG8_SA(0, 1), cA + hstepA, voffA);
        if (wr == 1) PG8_BAR;
        PG8_WAIT_V(4); PG8_BAR;
        PG8_STAGE(PG8_SB(1, 0), cB + kstep, voffB); PG8_STAGE(PG8_SA(1, 0), cA + kstep, voffA); PG8_STAGE(PG8_SB(1, 1), cB + hstepB + kstep, voffB);
        PG8_WAIT_V(6); PG8_BAR;
    }
    for (;;) {
        const bool has_next = S.next(ui + 1, nxt);
        const char* nA = has_next ? (const char*)g.A + (size_t)nxt.pm * tstepA : cA; const char* nB = has_next ? (const char*)g.Bt + (size_t)nxt.pn * tstepB : cB;
        for (int t = 0; t < nt; t += 2) {
            const bool last = (t == nt - 2);
            const char* a1 = cA + (size_t)(t + 1) * kstep;
            const char* a2 = last ? nA : cA + (size_t)(t + 2) * kstep; const char* b2 = last ? nB : cB + (size_t)(t + 2) * kstep;
            const char* a3 = a2 + kstep; const char* b3 = b2 + kstep;
            if (last && has_next) S.a_ready(nxt);
            if constexpr (SP2) {
            PG8_LDB(B0, 0, 0); PG8_LDB(B1, 0, 1); PG8_SCHED; PG8_LDA(At, 0, 0); PG8_STAGE(PG8_SA(1, 1), a1 + hstepA, voffA);
            PG8_WAIT_V(8); PG8_WAIT_L(0); PG8_BAR; PG8_MMA(0, 0, At, B0); PG8_MMA(0, 1, At, B1); PG8_BAR; PG8_SCHED;
            PG8_LDA(At, 0, 1); PG8_STAGE(PG8_SB(0, 0), b2, voffB); PG8_STAGE(PG8_SB(0, 1), b2 + hstepB, voffB); PG8_STAGE(PG8_SA(0, 0), a2, voffA);
            PG8_WAIT_V(8); PG8_WAIT_L(0); PG8_BAR; PG8_MMA(1, 0, At, B0); PG8_MMA(1, 1, At, B1); PG8_BAR; PG8_SCHED;
            PG8_LDB(B0, 1, 0); PG8_LDB(B1, 1, 1); PG8_SCHED; PG8_LDA(At, 1, 0); PG8_STAGE(PG8_SA(0, 1), a2 + hstepA, voffA);
            PG8_WAIT_V(8); PG8_WAIT_L(0); PG8_BAR; PG8_MMA(0, 0, At, B0); PG8_MMA(0, 1, At, B1); PG8_BAR; PG8_SCHED;
            PG8_LDA(At, 1, 1); PG8_STAGE(PG8_SB(1, 0), b3, voffB); PG8_STAGE(PG8_SB(1, 1), b3 + hstepB, voffB); PG8_STAGE(PG8_SA(1, 0), a3, voffA);
            PG8_WAIT_V(8); PG8_WAIT_L(0); PG8_BAR; PG8_MMA(1, 0, At, B0); PG8_MMA(1, 1, At, B1); PG8_BAR; PG8_SCHED;
            } else {
            PG8_LDB(B0, 0, 0); PG8_SCHED; PG8_LDA(At, 0, 0); PG8_STAGE(PG8_SA(1, 1), a1 + hstepA, voffA);
            PG8_WAIT_L(8); PG8_BAR; PG8_WAIT_L(0); PG8_MMA(0, 0, At, B0); PG8_BAR; PG8_SCHED;
            PG8_LDB(B1, 0, 1); PG8_STAGE(PG8_SB(0, 0), b2, voffB);
            PG8_BAR; PG8_WAIT_L(0); PG8_MMA(0, 1, At, B1); PG8_BAR;
            PG8_LDA(At, 0, 1); PG8_STAGE(PG8_SA(0, 0), a2, voffA);
            PG8_BAR; PG8_WAIT_L(0); PG8_MMA(1, 0, At, B0); PG8_BAR; PG8_SCHED;
            PG8_STAGE(PG8_SB(0, 1), b2 + hstepB, voffB);
            PG8_WAIT_V(6); PG8_BAR; PG8_MMA(1, 1, At, B1); PG8_BAR;
            PG8_LDB(B0, 1, 0); PG8_SCHED; PG8_LDA(At, 1, 0); PG8_STAGE(PG8_SA(0, 1), a2 + hstepA, voffA);
            PG8_WAIT_L(8); PG8_BAR; PG8_WAIT_L(0); PG8_MMA(0, 0, At, B0); PG8_BAR; PG8_SCHED;
            PG8_LDB(B1, 1, 1); PG8_STAGE(PG8_SB(1, 0), b3, voffB);
            PG8_BAR; PG8_WAIT_L(0); PG8_MMA(0, 1, At, B1); PG8_BAR;
            PG8_LDA(At, 1, 1); PG8_STAGE(PG8_SA(1, 0), a3, voffA);
            PG8_BAR; PG8_WAIT_L(0); PG8_MMA(1, 0, At, B0); PG8_BAR; PG8_SCHED;
            PG8_STAGE(PG8_SB(1, 1), b3 + hstepB, voffB);
            PG8_WAIT_V(6); PG8_BAR; PG8_MMA(1, 1, At, B1); PG8_BAR;
            }
        }
        if constexpr (ALIGN_EPI) { if (wr == 0) PG8_BAR; }
        if constexpr (!Epi::AFTER_DRAIN) {
            f32x4 accf[2][2][4][2];
#pragma unroll
            for (int a = 0; a < 2; ++a)
#pragma unroll
                for (int b = 0; b < 2; ++b)
#pragma unroll
                    for (int m = 0; m < 4; ++m)
#pragma unroll
                        for (int n = 0; n < 2; ++n) accf[a][b][m][n] = __builtin_convertvector(acc[a][b][m][n], f32x4);
            E(accf, cur, wr, wc, fr, fq); S.done(cur); }
        if (!has_next) break;
#pragma unroll
        for (int a = 0; a < 2; ++a)
#pragma unroll
            for (int b = 0; b < 2; ++b)
#pragma unroll
                for (int m = 0; m < 4; ++m)
#pragma unroll
                    for (int n = 0; n < 2; ++n) acc[a][b][m][n] = (i32x4){0, 0, 0, 0};
        cur = nxt; cA = nA; cB = nB; ++ui;
        if constexpr (ALIGN_EPI) { if (wr == 1) PG8_BAR; }
    }
    PG8_WAIT_V(0);
    if constexpr (!ALIGN_EPI) { if (wr == 0) PG8_BAR; }
    PG8_BAR;
#undef PG8_SA
#undef PG8_SB
#undef PG8_STAGE
#undef PG8_LDA
#undef PG8_LDB
#undef PG8_MMA
#undef PG8_WAIT_V
#undef PG8_WAIT_L
#undef PG8_BAR
#undef PG8_SCHED
}
}
#define GAS __attribute__((address_space(1)))
#define LAS __attribute__((address_space(3)))
typedef unsigned short bf16;
typedef unsigned v4u __attribute__((ext_vector_type(4)));
typedef float f32x4 __attribute__((ext_vector_type(4)));
typedef short bf16x8 __attribute__((ext_vector_type(8)));
typedef GAS unsigned gu32;
typedef GAS unsigned long long gu64;
#define RLX_AGENT __ATOMIC_RELAXED, __HIP_MEMORY_SCOPE_AGENT
#define LDS_WAIT() asm volatile("s_waitcnt lgkmcnt(0)" ::: "memory")
#define VM_WAIT() asm volatile("s_waitcnt vmcnt(0)" ::: "memory")
__device__ __forceinline__ unsigned long long rt() { return __builtin_amdgcn_s_memrealtime(); }
__device__ __forceinline__ unsigned f2bf(float f) { unsigned u = __builtin_bit_cast(unsigned, f); return (u + 0x7fffu + ((u >> 16) & 1u)) >> 16; }
typedef __bf16 hw_bf16x2 __attribute__((ext_vector_type(2))); typedef float hw_f32x2 __attribute__((ext_vector_type(2)));
__device__ __forceinline__ unsigned pk2(float lo, float hi) { const hw_f32x2 v = {lo, hi}; return __builtin_bit_cast(unsigned, __builtin_convertvector(v, hw_bf16x2)); }

#define XB_TMO      128
#define XB_XCNT(j)  (256  + 64 * (j))
#define XB_XSUB(j)  (1280 + 64 * (j))
#define XB_XGEN(j)  (2304 + 64 * (j))
#define XB_TOP      3328
#define XB_TOPGEN   3392
#define XCD_BAR_WORDS 3456
#define XB_SPIN_CAP (1u << 18)

__device__ __forceinline__ unsigned xb_ld(unsigned* p)              { return __hip_atomic_load(p, __ATOMIC_RELAXED, __HIP_MEMORY_SCOPE_AGENT); }
__device__ __forceinline__ unsigned xb_add(unsigned* p, unsigned v) { return __hip_atomic_fetch_add(p, v, __ATOMIC_RELAXED, __HIP_MEMORY_SCOPE_AGENT); }
__device__ __forceinline__ unsigned xb_xcc_id() { return (unsigned)__builtin_amdgcn_s_getreg((3 << 11) | 20) & 0xFu; }
#define XB_SPIN(cond, bar) do { unsigned _sp = 0; while (cond) { __builtin_amdgcn_s_sleep(1); \
    if ((++_sp & 255u) == 0u) { if (xb_ld(&(bar)[XB_TMO])) break; if (_sp > XB_SPIN_CAP) { atomicAdd(&(bar)[XB_TMO], 1u); break; } } } } while (0)

struct XcdBarrier {
    unsigned* bar; unsigned x;
    volatile LAS unsigned* st;
};

__device__ __forceinline__ XcdBarrier xcd_barrier_post(unsigned* bar, volatile LAS unsigned* st) {
    XcdBarrier b; b.bar = bar; b.x = xb_xcc_id(); b.st = st;
    if (threadIdx.x == 0) (void)xb_add(&bar[XB_XCNT(b.x)], 1u);
    return b;
}
__device__ __forceinline__ void xcd_barrier_complete(unsigned* bar, unsigned x, unsigned& nloc, unsigned& nx) {
    const unsigned G = gridDim.x * gridDim.y * gridDim.z;
    unsigned sum, cnt, mine, sp = 0u;
    for (;;) {
        sum = 0u; cnt = 0u; mine = 0u;
#pragma unroll
        for (unsigned j = 0; j < 16; ++j) { const unsigned c = xb_ld(&bar[XB_XCNT(j)]); sum += c; cnt += (c > 0u) ? 1u : 0u; mine = (j == x) ? c : mine; }
        if (sum == G) break;
        __builtin_amdgcn_s_sleep(1);
        if ((++sp & 255u) == 0u) { if (xb_ld(&bar[XB_TMO])) break; if (sp > XB_SPIN_CAP) { atomicAdd(&bar[XB_TMO], 1u); break; } }
    }
    nloc = mine > 0u ? mine : 1u; nx = cnt > 0u ? cnt : 1u;
}

__device__ __forceinline__ void xcd_barrier(const XcdBarrier& b) {
    asm volatile("s_waitcnt vmcnt(0)" ::: "memory");
    __syncthreads();
    if (threadIdx.x == 0) {
        unsigned* bar = b.bar;
        __builtin_amdgcn_s_waitcnt(0);
        unsigned nloc = b.st[0], nx = b.st[1];
        if (nloc == 0u) { xcd_barrier_complete(bar, b.x, nloc, nx); b.st[0] = nloc; b.st[1] = nx; }
        const unsigned old = xb_add(&bar[XB_XSUB(b.x)], 1u);
        const unsigned gen = old / nloc;
        if (old + 1u == (gen + 1u) * nloc) {
            __builtin_amdgcn_fence(__ATOMIC_RELEASE, "agent");
            asm volatile("s_waitcnt vmcnt(0)" ::: "memory");
            const unsigned og = xb_add(&bar[XB_TOP], 1u);
            const unsigned tg = og / nx;
            if (og + 1u == (tg + 1u) * nx) xb_add(&bar[XB_TOPGEN], 1u);
            else XB_SPIN(xb_ld(&bar[XB_TOPGEN]) == tg, bar);
            __builtin_amdgcn_fence(__ATOMIC_ACQUIRE, "agent");
            xb_add(&bar[XB_XGEN(b.x)], 1u);
            asm volatile("s_waitcnt vmcnt(0)" ::: "memory");
        } else {
            XB_SPIN(xb_ld(&bar[XB_XGEN(b.x)]) == gen, bar);
            __builtin_amdgcn_fence(__ATOMIC_ACQUIRE, "agent");
            asm volatile("s_waitcnt vmcnt(0)" ::: "memory");
        }
    }
    __syncthreads();
}

constexpr int NWAVES = 8;
constexpr int BATCH = 2, SEQ = 4096, DM = 4096, M = BATCH * SEQ;
constexpr int NH = 64, NKV = 8, HD = 64, QKVW = 5120;
constexpr int FF = 11008, NUP = 2 * FF;
constexpr int SG = 256, SGC = 16, SP = 64;
constexpr float EPS = 1e-6f;
constexpr int LDX = DM + 128, LDACT = FF + 128;
constexpr int LDW = DM + 128, LDWF = FF + 128;
#ifndef MK_N_LAUNCHES
#define MK_N_LAUNCHES 1
#endif
constexpr int N_PHASES = 13;
constexpr int N_LAUNCHES = MK_N_LAUNCHES;

constexpr size_t MiB = 1u << 20;
constexpr size_t WS_CTL = 0, CTL_ZERO_BYTES = 1 * MiB;
constexpr size_t WS_WQKV = 2 * MiB;
constexpr size_t WS_WO   = WS_WQKV + 42 * MiB;
constexpr size_t WS_WUP0 = WS_WO + 34 * MiB;
constexpr size_t WS_WUP1 = WS_WUP0 + 178 * MiB;
constexpr size_t WS_WDN0 = WS_WUP1 + 178 * MiB;
constexpr size_t WS_WDN1 = WS_WDN0 + 88 * MiB;
constexpr size_t WS_WGLU = WS_WDN1 + 88 * MiB;
constexpr size_t WS_X    = WS_WGLU + 67 * MiB;
constexpr size_t WS_XN   = WS_X + 128 * MiB;
constexpr size_t WS_QKV  = WS_XN + 67 * MiB;
constexpr size_t WS_AO   = WS_QKV + 80 * MiB;
constexpr size_t WS_ACT  = WS_AO + 67 * MiB;
constexpr size_t WS_HEAD = WS_ACT + 175 * MiB;
constexpr size_t WS_TAIL = WS_HEAD + 22 * MiB;
constexpr size_t WS_S5KT = WS_TAIL + 22 * MiB;
constexpr size_t WS_S5BE = WS_S5KT + 5 * MiB;
constexpr size_t WS_S5CP = WS_S5BE + 32 * MiB;
constexpr size_t WS_S5AT = WS_S5CP + 32 * MiB;
constexpr size_t WS_S5H  = WS_S5AT + 1 * MiB;
#ifndef UP0_I8_TILES
#define UP0_I8_TILES 48
#endif
constexpr int NI8 = UP0_I8_TILES * 256;
constexpr int LDQ = DM + 256;
constexpr size_t WS_XQ   = WS_S5H + 64 * MiB;
constexpr size_t WS_WQ1  = WS_XQ + 36 * MiB;
constexpr size_t WS_ASC  = WS_WQ1 + 92 * MiB;
constexpr size_t WS_WSC1 = WS_ASC + 1 * MiB;
constexpr size_t WS_WQ0  = WS_WSC1 + 1 * MiB;
constexpr size_t WS_WSC0 = WS_WQ0 + 92 * MiB;
constexpr size_t WS_XNB  = WS_WSC0 + 1 * MiB;
constexpr size_t WS_END  = WS_XNB + 67 * MiB;
static_assert((size_t)M * LDQ <= 36 * MiB && (size_t)NUP * LDQ <= 92 * MiB, "int8 ws map");
constexpr size_t WS_SS = 262144;
static_assert((size_t)QKVW * LDW * 2 <= 42 * MiB && (size_t)DM * LDW * 2 <= 34 * MiB && (size_t)NUP * LDW * 2 <= 178 * MiB && (size_t)DM * LDWF * 2 <= 88 * MiB && (size_t)2 * DM * LDW * 2 <= 67 * MiB && (size_t)M * LDX * 2 <= 67 * MiB && (size_t)M * LDACT * 2 <= 175 * MiB && (size_t)(M / 64) * 2 * NUP * 4 <= 22 * MiB, "ws map");
constexpr int CW_BAR = 4096;

constexpr int RING_OFF = 0, RING_BYTES = 131072;
constexpr int LDSCTL_OFF = RING_BYTES, MISC_OFF = LDSCTL_OFF + 320;
constexpr int LDS_BYTES = 147456;
static_assert(MISC_OFF + 128 <= LDS_BYTES, "LDS map");

typedef unsigned v2u __attribute__((ext_vector_type(2)));
using pg8::ssq_t; using pg8::ss_get; using pg8::ss_fix; using pg8::xpk; using pg8::xlo; using pg8::xhi;
struct Frame {
    LAS unsigned char* lds;
    volatile LAS unsigned* MISC;
    gu32* ctl;
    int tid, lane, wave;
    int vcu, G;
};
__device__ __forceinline__ float wave_sum(float v) {
#pragma unroll
    for (int o = 1; o < 64; o <<= 1) v += __shfl_xor(v, o);
    return v;
}
__device__ __forceinline__ float bf_lo(unsigned w) { return __uint_as_float(w << 16); }
__device__ __forceinline__ float bf_hi(unsigned w) { return __uint_as_float(w & 0xffff0000u); }

__device__ __forceinline__ int rowmap(int n, int Hh) { if (Hh == 0) return n; const int half = n >= Hh ? 1 : 0; const int f = n - half * Hh; return ((f >> 7) << 8) + (half << 7) + (f & 127); }
struct CvtJob { const float* W; bf16* WT; const float* gain; int N, ldw, Hh, k0, n0, kgl, h16; };
constexpr int CI_QKV = (DM / 64) * (QKVW / 32), CI_O = (DM / 64) * (DM / 32), CI_UP = (DM / 64) * (NUP / 32), CI_DN = (FF / 64) * (DM / 32), CI_GLU = (DM / 64) * (2 * DM / 32);
constexpr int CI_UP0 = (DM / 64) * ((NUP - NI8) / 32);
static_assert(((NUP - NI8) / 32) % 16 == 0 && (NI8 / 2) % 32 == 0, "bf16 part of the layer-0 up weights: whole super-blocks");
constexpr int CVT_ITEMS = CI_QKV + CI_O + CI_UP0 + 2 * CI_DN + CI_GLU;
#ifndef CVT_Q1
#define CVT_Q1 12
#endif
#ifndef CVT_Q2
#define CVT_Q2 14
#endif
constexpr int CVT_W1 = 128 * NWAVES, CVT_W2 = 64 * NWAVES;
constexpr int CVT_N1 = CVT_W1 * CVT_Q1, CVT_N2 = CVT_W2 * CVT_Q2, CVT_NP = CVT_ITEMS - CVT_N1 - CVT_N2;
static_assert(CVT_NP >= CI_QKV + CI_O + CI_UP0 + CI_DN, "the prologue must convert everything layer 0 needs");
__device__ __forceinline__ CvtJob cvt_job(int it, const float* const* in, unsigned char* ws) {
    CvtJob j; int r = it; j.gain = nullptr; bool up0 = false;
    j.h16 = 0;
    if (r < CI_QKV) { j.W = in[2]; j.WT = (bf16*)(ws + WS_WQKV); j.N = QKVW; j.ldw = LDW; j.Hh = 0; j.gain = in[1]; j.kgl = 3; }
    else if ((r -= CI_QKV) < CI_O) { j.W = in[3]; j.WT = (bf16*)(ws + WS_WO); j.N = DM; j.ldw = LDW; j.Hh = 0; j.kgl = 3; }
    else if ((r -= CI_O) < CI_UP0) { up0 = true; j.W = in[17]; j.WT = (bf16*)(ws + WS_WUP0); j.N = NUP; j.ldw = LDW; j.Hh = FF; j.gain = in[16]; j.kgl = 4; }
    else if ((r -= CI_UP0) < CI_DN) { j.W = in[20]; j.WT = (bf16*)(ws + WS_WDN0); j.N = DM; j.ldw = LDWF; j.Hh = 0; j.kgl = 2; }
    else if ((r -= CI_DN) < CI_GLU) { j.W = in[15]; j.WT = (bf16*)(ws + WS_WGLU); j.N = 2 * DM; j.ldw = LDW; j.Hh = DM; j.kgl = 3; }
    else { r -= CI_GLU; j.W = in[20] + (size_t)FF * DM; j.WT = (bf16*)(ws + WS_WDN1); j.N = DM; j.ldw = LDWF; j.Hh = 0; j.kgl = 2; }
    const int ngl = 8 - j.kgl, nblk = up0 ? (NUP - NI8) >> 5 : j.N >> 5, ngrp = nblk >> ngl;
    const int sb = r >> 8, wi = r & 255, kgi = sb / ngrp, ngi = sb - kgi * ngrp;
    const int kb = (kgi << j.kgl) + (wi >> ngl), nb = (ngi << ngl) + (wi & ((1 << ngl) - 1));
    j.k0 = 64 * kb; j.n0 = 32 * nb;
    if (up0) j.n0 += (j.n0 < (NUP - NI8) / 2) ? NI8 / 2 : NI8 / 2 + NI8 / 2;
    return j;
}
__device__ __forceinline__ void cvt_load(const CvtJob& j, int lane, f32x4 (&v)[8], float (&gk)[8]) {
    const float* p = j.W + (size_t)(j.k0 + (lane >> 3)) * j.N + j.n0 + 4 * (lane & 7);
#pragma unroll
    for (int i = 0; i < 8; ++i) v[i] = __builtin_nontemporal_load((const GAS f32x4*)(p + (size_t)(8 * i) * j.N));
    const float* gp = (j.gain ? j.gain : j.W) + j.k0 + (lane >> 3);
#pragma unroll
    for (int i = 0; i < 8; ++i) { const float t = gp[8 * i]; gk[i] = j.gain ? t : 1.0f; }
}
__device__ __forceinline__ void cvt_store(const CvtJob& j, int lane, const f32x4 (&v)[8], const float (&gk)[8], LAS float* scr) {
    const int kr = lane >> 3, nq = 4 * (lane & 7);
#pragma unroll
    for (int i = 0; i < 8; ++i) { LAS float* d = scr + (8 * i + kr) * 33 + nq; d[0] = v[i].x * gk[i]; d[1] = v[i].y * gk[i]; d[2] = v[i].z * gk[i]; d[3] = v[i].w * gk[i]; }
    LDS_WAIT(); asm volatile("" ::: "memory");
    const int c = lane & 7; const int r0 = rowmap(j.n0, j.Hh);
#pragma unroll
    for (int jj = 0; jj < 4; ++jj) { const int n = (lane >> 3) + 8 * jj; const LAS float* s = scr + (8 * c) * 33 + n;
        v4u o;
        if (j.h16) { o.x = xpk(s[0 * 33], s[1 * 33]); o.y = xpk(s[2 * 33], s[3 * 33]); o.z = xpk(s[4 * 33], s[5 * 33]); o.w = xpk(s[6 * 33], s[7 * 33]); }
        else { o.x = pk2(s[0 * 33], s[1 * 33]); o.y = pk2(s[2 * 33], s[3 * 33]); o.z = pk2(s[4 * 33], s[5 * 33]); o.w = pk2(s[6 * 33], s[7 * 33]); }
        __builtin_nontemporal_store(o, (GAS v4u*)(j.WT + (size_t)(r0 + n) * j.ldw + j.k0 + 8 * c)); }
    LDS_WAIT(); asm volatile("" ::: "memory");
}
__device__ __forceinline__ void convert_weights(Frame& F, const float* const* in, unsigned char* ws, int first, int count, int rank, int nwaves) {
    LAS float* scr = (LAS float*)(F.lds + RING_OFF + F.wave * 16384);
    const int end = first + count, last = end - 1;
    int it = first + rank; if (it >= end) return;
    CvtJob jA = cvt_job(it, in, ws); f32x4 vA[8]; float gA[8]; cvt_load(jA, F.lane, vA, gA);
    CvtJob jB = cvt_job(min(it + nwaves, last), in, ws); f32x4 vB[8]; float gB[8]; cvt_load(jB, F.lane, vB, gB);
    for (; it < end; it += 2 * nwaves) {
        cvt_store(jA, F.lane, vA, gA, scr);                     asm volatile("" ::: "memory");
        jA = cvt_job(min(it + 2 * nwaves, last), in, ws); cvt_load(jA, F.lane, vA, gA);   asm volatile("" ::: "memory");
        if (it + nwaves < end) cvt_store(jB, F.lane, vB, gB, scr);   asm volatile("" ::: "memory");
        jB = cvt_job(min(it + 3 * nwaves, last), in, ws); cvt_load(jB, F.lane, vB, gB);   asm volatile("" ::: "memory");
    }
}
__device__ __forceinline__ unsigned q4(float a, float b, float c, float e, float inv) {
    const int i0 = __float2int_rn(a * inv), i1 = __float2int_rn(b * inv), i2 = __float2int_rn(c * inv), i3 = __float2int_rn(e * inv);
    return (unsigned)(i0 & 0xff) | ((unsigned)(i1 & 0xff) << 8) | ((unsigned)(i2 & 0xff) << 16) | ((unsigned)(i3 & 0xff) << 24);
}
constexpr int NPAN0 = NI8 / 32, NPAN1 = NUP / 32, NPAN = NPAN0 + NPAN1;
__device__ __forceinline__ void convert_panels(Frame& F, const float* const* in, unsigned char* ws, int first, int count, int rank, int nwg) {
    LAS unsigned char* pan = F.lds + RING_OFF;
    LAS unsigned* cmax = (LAS unsigned*)(F.lds + LDSCTL_OFF + 1024);
    const int t = F.tid, c8 = t & 7, r = t >> 3;
    const int end = first + count;
#define PAN_R0(p_) (32 * ((p_) >= NPAN0 ? (p_) - NPAN0 : (p_)))
#define PAN_SRC(p_) (in[17] + ((p_) >= NPAN0 ? (size_t)DM * NUP : (size_t)0) + (((PAN_R0(p_) >> 7) & 1) * FF + (PAN_R0(p_) >> 8) * 128 + (PAN_R0(p_) & 127)) + 4 * c8 + (size_t)(2 * r) * NUP)
#define PAN_LOAD(dst_, src_, b_) do { const float* q_ = (src_) + (size_t)(512 * (b_)) * NUP; asm volatile("" : "+v"(q_));     \
        _Pragma("unroll") for (int i = 0; i < 8; ++i) dst_[i] = __builtin_nontemporal_load((const GAS f32x4*)(q_ + (size_t)(128 * (i >> 1) + (i & 1)) * NUP)); } while (0)
#define PAN_PUT(src_, b_) do { \
        _Pragma("unroll") for (int i = 0; i < 4; ++i) { const unsigned gw = *(const LAS unsigned*)(gl + 4 * (r + 64 * (4 * (b_) + i))); const float ge = xlo(gw), go = xhi(gw); \
            const f32x4 a = src_[2 * i] * ge, c = src_[2 * i + 1] * go; \
            am0 = fmaxf(am0, fmaxf(fabsf(a.x), fabsf(c.x))); am1 = fmaxf(am1, fmaxf(fabsf(a.y), fabsf(c.y))); am2 = fmaxf(am2, fmaxf(fabsf(a.z), fabsf(c.z))); am3 = fmaxf(am3, fmaxf(fabsf(a.w), fabsf(c.w))); \
            LAS unsigned char* d = pan + (2 * c8) * 8192 + (((unsigned)(4 * (r + 64 * (4 * (b_) + i)))) ^ ((unsigned)c8 << 5)); \
            *(LAS unsigned*)(d) = xpk(a.x, c.x); *(LAS unsigned*)(d + 8192) = xpk(a.y, c.y); pz[4 * (b_) + i] = xpk(a.z, c.z); pw[4 * (b_) + i] = xpk(a.w, c.w); } } while (0)
#define PAN_QUANT(hi_) do { int tq = threadIdx.x; asm volatile("" : "+v"(tq)); const int slot = tq >> 5, l = tq & 31, col = 4 * (slot >> 1) + 2 * (hi_) + (slot & 1); const float mx = __uint_as_float(cmax[col]); const float inv = mx > 0.f ? 127.0f / mx : 0.f; \
        const unsigned key = (unsigned)(slot >> 1) << 5; GAS v2u* qo = (GAS v2u*)(Q + (size_t)(r0 + col) * LDQ); \
        _Pragma("unroll 4") for (int i = 0; i < 16; ++i) { const int ch = l + 32 * i; const v4u w = *(const LAS v4u*)(pan + slot * 8192 + (((unsigned)(16 * ch)) ^ key)); \
            v2u o; o.x = q4(xlo(w.x), xhi(w.x), xlo(w.y), xhi(w.y), inv); o.y = q4(xlo(w.z), xhi(w.z), xlo(w.w), xhi(w.w), inv); qo[ch] = o; } \
        if (l == 0) sc[r0 + col] = mx * (1.0f / 127.0f); } while (0)
    int p = first + rank; if (p >= end) return;
    f32x4 v0[8], v1[8]; unsigned pz[32], pw[32];
    LAS unsigned char* gl = F.lds + LDSCTL_OFF + 1280;
    int cur = -1;
    PAN_LOAD(v0, PAN_SRC(p), 0);
    __syncthreads();
    for (; p < end; p += nwg) {
        const bool l1 = p >= NPAN0; const int r0 = PAN_R0(p);
        if ((int)l1 != cur) { cur = (int)l1; const float* gain = in[16] + (l1 ? DM : 0);
            for (int i = t; i < DM / 2; i += 512) *(LAS unsigned*)(gl + 4 * i) = xpk(gain[2 * i], gain[2 * i + 1]);
            __syncthreads(); }
        unsigned char* Q = ws + (l1 ? WS_WQ1 : WS_WQ0); float* sc = (float*)(ws + (l1 ? WS_WSC1 : WS_WSC0));
        { int tz_ = threadIdx.x; asm volatile("" : "+v"(tz_)); if (tz_ < 32) cmax[tz_] = 0u; }
        float am0 = 0.f, am1 = 0.f, am2 = 0.f, am3 = 0.f;
        const float* src = PAN_SRC(p);
        PAN_LOAD(v1, src, 1); PAN_PUT(v0, 0); asm volatile("" ::: "memory");
        PAN_LOAD(v0, src, 2); PAN_PUT(v1, 1); asm volatile("" ::: "memory");
        PAN_LOAD(v1, src, 3); PAN_PUT(v0, 2); asm volatile("" ::: "memory");
        PAN_LOAD(v0, src, 4); PAN_PUT(v1, 3); asm volatile("" ::: "memory");
        PAN_LOAD(v1, src, 5); PAN_PUT(v0, 4); asm volatile("" ::: "memory");
        PAN_LOAD(v0, src, 6); PAN_PUT(v1, 5); asm volatile("" ::: "memory");
        PAN_LOAD(v1, src, 7); PAN_PUT(v0, 6); asm volatile("" ::: "memory");
        { const int pnx = (p + nwg < end) ? p + nwg : p; PAN_LOAD(v0, PAN_SRC(pnx), 0); }
        PAN_PUT(v1, 7); asm volatile("" ::: "memory");
#pragma unroll
        for (int o = 8; o < 64; o <<= 1) { am0 = fmaxf(am0, __shfl_xor(am0, o)); am1 = fmaxf(am1, __shfl_xor(am1, o)); am2 = fmaxf(am2, __shfl_xor(am2, o)); am3 = fmaxf(am3, __shfl_xor(am3, o)); }
        __syncthreads();
        if (F.lane < 8) { atomicMax((unsigned*)(cmax + 4 * c8), __float_as_uint(am0)); atomicMax((unsigned*)(cmax + 4 * c8 + 1), __float_as_uint(am1)); atomicMax((unsigned*)(cmax + 4 * c8 + 2), __float_as_uint(am2)); atomicMax((unsigned*)(cmax + 4 * c8 + 3), __float_as_uint(am3)); }
        __syncthreads();
        PAN_QUANT(0);
        __syncthreads();
#pragma unroll
        for (int i = 0; i < 32; ++i) { LAS unsigned char* d = pan + (2 * c8) * 8192 + (((unsigned)(4 * (r + 64 * i))) ^ ((unsigned)c8 << 5)); *(LAS unsigned*)(d) = pz[i]; *(LAS unsigned*)(d + 8192) = pw[i]; }
        __syncthreads();
        PAN_QUANT(1);
        __syncthreads();
    }
#undef PAN_R0
#undef PAN_SRC
#undef PAN_LOAD
#undef PAN_PUT
#undef PAN_QUANT
}
__device__ __forceinline__ void x0_rows(Frame& F, const float* src, bf16* xb, bf16* xb2, ssq_t* ss) {
    const int gw = F.vcu * NWAVES + F.wave, NGW = F.G * NWAVES;
    for (int m = gw; m < M; m += NGW) {
        const GAS f32x4* xr = (const GAS f32x4*)(src + (size_t)m * DM) + F.lane;
        GAS unsigned long long* o8 = (GAS unsigned long long*)(xb + (size_t)m * LDX) + F.lane; float s = 0.f;
        GAS unsigned long long* p8 = (GAS unsigned long long*)(xb2 + (size_t)m * LDX) + F.lane;
#pragma unroll
        for (int j = 0; j < 16; ++j) { const f32x4 v = xr[64 * j]; const unsigned w0 = xpk(v.x, v.y), w1 = xpk(v.z, v.w); o8[64 * j] = (unsigned long long)w0 | ((unsigned long long)w1 << 32); { const unsigned b0 = pk2(v.x, v.y), b1 = pk2(v.z, v.w); p8[64 * j] = (unsigned long long)b0 | ((unsigned long long)b1 << 32); }
            const float a = xlo(w0), b = xhi(w0), c = xlo(w1), d = xhi(w1); s += (a * a + b * b) + (c * c + d * d); }
        s = wave_sum(s); if (F.lane == 0) ss[m] = ss_fix(s);
    }
}
__device__ __forceinline__ void final_rows(Frame& F, const bf16* xb, const ssq_t* ss, const float* gain, float* dst) {
    const int gw = F.vcu * NWAVES + F.wave, NGW = F.G * NWAVES;
    int lane_ = threadIdx.x; asm volatile("" : "+v"(lane_)); lane_ &= 63;
    for (int m = gw; m < M; m += NGW) {
        const float rstd = 1.0f / sqrtf(ss_get(ss, m) * (1.0f / DM) + EPS);
        const GAS v4u* xr = (const GAS v4u*)(xb + (size_t)m * LDX) + lane_; const GAS f32x4* gr = (const GAS f32x4*)gain + 2 * lane_; GAS f32x4* o = (GAS f32x4*)(dst + (size_t)m * DM) + 2 * lane_;
        v4u w[8];
#pragma unroll
        for (int j = 0; j < 8; ++j) w[j] = xr[64 * j];
#pragma unroll
        for (int j = 0; j < 8; ++j) { const f32x4 g0 = gr[128 * j], g1 = gr[128 * j + 1]; f32x4 r0, r1;
            r0.x = xlo(w[j].x) * rstd * g0.x; r0.y = xhi(w[j].x) * rstd * g0.y; r0.z = xlo(w[j].y) * rstd * g0.z; r0.w = xhi(w[j].y) * rstd * g0.w;
            r1.x = xlo(w[j].z) * rstd * g1.x; r1.y = xhi(w[j].z) * rstd * g1.y; r1.z = xlo(w[j].w) * rstd * g1.z; r1.w = xhi(w[j].w) * rstd * g1.w;
            o[128 * j] = r0; o[128 * j + 1] = r1; }
    }
}
__device__ __forceinline__ float wave_max(float v) {
#pragma unroll
    for (int o = 1; o < 64; o <<= 1) v = fmaxf(v, __shfl_xor(v, o));
    return v;
}
template <bool XH> __device__ __forceinline__ float qlo(unsigned w) { if constexpr (XH) return xlo(w); else return bf_lo(w); }
template <bool XH> __device__ __forceinline__ float qhi(unsigned w) { if constexpr (XH) return xhi(w); else return bf_hi(w); }
template <bool XH>
__device__ __forceinline__ void quant_rows(Frame& F, const bf16* X, int row0, int nrows, int ld, unsigned char* Q, float* scale, const ssq_t* ss, int gw, int NGW) {
    for (int m = row0 + gw; m < nrows; m += 2 * NGW) {
        const int m1 = m + NGW; const bool two = m1 < nrows; const int mb = two ? m1 : m;
        const GAS v4u* xr = (const GAS v4u*)(X + (size_t)m * ld) + F.lane; const GAS v4u* xs = (const GAS v4u*)(X + (size_t)mb * ld) + F.lane;
        v4u w[8], z[8]; float mx = 0.f, my = 0.f;
#pragma unroll
        for (int j = 0; j < 8; ++j) w[j] = xr[64 * j];
#pragma unroll
        for (int j = 0; j < 8; ++j) z[j] = xs[64 * j];
        float rs0 = 1.0f, rs1 = 1.0f;
        if (ss) { rs0 = 1.0f / sqrtf(ss_get(ss, m) * (1.0f / DM) + EPS); rs1 = 1.0f / sqrtf(ss_get(ss, mb) * (1.0f / DM) + EPS); }
#pragma unroll
        for (int j = 0; j < 8; ++j) {
            mx = fmaxf(mx, fmaxf(fmaxf(fabsf(qlo<XH>(w[j].x)), fabsf(qhi<XH>(w[j].x))), fmaxf(fabsf(qlo<XH>(w[j].y)), fabsf(qhi<XH>(w[j].y)))));
            mx = fmaxf(mx, fmaxf(fmaxf(fabsf(qlo<XH>(w[j].z)), fabsf(qhi<XH>(w[j].z))), fmaxf(fabsf(qlo<XH>(w[j].w)), fabsf(qhi<XH>(w[j].w))))); }
#pragma unroll
        for (int j = 0; j < 8; ++j) {
            my = fmaxf(my, fmaxf(fmaxf(fabsf(qlo<XH>(z[j].x)), fabsf(qhi<XH>(z[j].x))), fmaxf(fabsf(qlo<XH>(z[j].y)), fabsf(qhi<XH>(z[j].y)))));
            my = fmaxf(my, fmaxf(fmaxf(fabsf(qlo<XH>(z[j].z)), fabsf(qhi<XH>(z[j].z))), fmaxf(fabsf(qlo<XH>(z[j].w)), fabsf(qhi<XH>(z[j].w))))); }
        mx = wave_max(mx); my = wave_max(my);
        const float inv = mx > 0.f ? 127.0f / mx : 0.f, inw = my > 0.f ? 127.0f / my : 0.f;
        GAS v2u* qo = (GAS v2u*)(Q + (size_t)m * LDQ) + F.lane;
#pragma unroll
        for (int j = 0; j < 8; ++j) { v2u o; o.x = q4(qlo<XH>(w[j].x), qhi<XH>(w[j].x), qlo<XH>(w[j].y), qhi<XH>(w[j].y), inv); o.y = q4(qlo<XH>(w[j].z), qhi<XH>(w[j].z), qlo<XH>(w[j].w), qhi<XH>(w[j].w), inv); qo[64 * j] = o; }
        if (F.lane == 0) scale[m] = mx * (1.0f / 127.0f) * rs0;
        if (two) {
            GAS v2u* qp = (GAS v2u*)(Q + (size_t)m1 * LDQ) + F.lane;
#pragma unroll
            for (int j = 0; j < 8; ++j) { v2u o; o.x = q4(qlo<XH>(z[j].x), qhi<XH>(z[j].x), qlo<XH>(z[j].y), qhi<XH>(z[j].y), inw); o.y = q4(qlo<XH>(z[j].z), qhi<XH>(z[j].z), qlo<XH>(z[j].w), qhi<XH>(z[j].w), inw); qp[64 * j] = o; }
            if (F.lane == 0) scale[m1] = my * (1.0f / 127.0f) * rs1;
        }
    }
}
__device__ __forceinline__ int t5_bucket(int n) { if (n < 16) return n; const int b = 16 + (int)(__log2f((float)n * 0.0625f) * (16.0f / 3.0f)); return b < 31 ? b : 31; }

typedef float f32x16 __attribute__((ext_vector_type(16)));
typedef __bf16 bf16x2_t __attribute__((ext_vector_type(2)));
typedef float f32x2_t __attribute__((ext_vector_type(2)));
__device__ __forceinline__ unsigned cvtpk(float lo, float hi) { f32x2_t v = {lo, hi}; bf16x2_t b = __builtin_convertvector(v, bf16x2_t); return __builtin_bit_cast(unsigned, b); }
#define MFMA32(a, b, c) __builtin_amdgcn_mfma_f32_32x32x16_bf16((a), (b), (c), 0, 0, 0)
constexpr int AT_KSTR = 144, AT_VSTR = 528;
constexpr int AT_LDS_K = 0, AT_LDS_V = 256 * AT_KSTR, AT_LDS_B = AT_LDS_V + 64 * AT_VSTR, AT_LDS_END = AT_LDS_B + NWAVES * 768;
static_assert(AT_LDS_END <= RING_BYTES, "attention LDS map");
__device__ __forceinline__ int crow16(int i, int h) { return (i & 3) + 8 * (i >> 2) + 4 * h; }
__device__ __forceinline__ void attn_mfma(Frame& F, const bf16* QKV, const float* sinks, const float* rel_bias, bf16* AO) {
    LAS unsigned char* Ks = F.lds + AT_LDS_K; LAS unsigned char* Vt = F.lds + AT_LDS_V; LAS float* tb = (LAS float*)(F.lds + AT_LDS_B + F.wave * 768);
    const int lane = F.lane, r = lane & 31, h = lane >> 5, w = F.wave;
    const float LOG2E = 1.4426950408889634f, SC = 0.125f * LOG2E;
    for (int unit = (int)blockIdx.x; unit < BATCH * 32 * NKV; unit += F.G) {
        const int kvh = unit & 7, nb = (unit >> 3) & 31, b = unit >> 8, head = kvh * 8 + w;
        for (int e = lane; e < 192; e += 64) { const int dist = e - 32; tb[e] = (dist >= 0 && dist < 128) ? rel_bias[t5_bucket(dist) * NH + head] * LOG2E : -1e30f; }
        const float sink2 = sinks[head] * LOG2E;
        const long long row0 = (long long)b * SEQ + (nb - 1) * 128;
#pragma unroll
        for (int i = 0; i < 4; ++i) {
            const int c = F.tid + 512 * i, key = c >> 3, dc = c & 7;
            if (nb > 0 || key >= 128) {
                const bf16* src = QKV + (size_t)(row0 + key) * QKVW + DM + kvh * 64 + dc * 8;
                const v4u kk = *(const v4u*)src, vv = *(const v4u*)(src + 512);
                *(LAS v4u*)(Ks + key * AT_KSTR + dc * 16) = kk;
                LAS unsigned short* vp = (LAS unsigned short*)(Vt + (dc * 8) * AT_VSTR + key * 2);
                vp[0 * 264] = (unsigned short)(vv.x & 0xffffu); vp[1 * 264] = (unsigned short)(vv.x >> 16); vp[2 * 264] = (unsigned short)(vv.y & 0xffffu); vp[3 * 264] = (unsigned short)(vv.y >> 16);
                vp[4 * 264] = (unsigned short)(vv.z & 0xffffu); vp[5 * 264] = (unsigned short)(vv.z >> 16); vp[6 * 264] = (unsigned short)(vv.w & 0xffffu); vp[7 * 264] = (unsigned short)(vv.w >> 16);
            }
        }
        bf16x8 qf[4];
        { const bf16* qp = QKV + ((size_t)b * SEQ + nb * 128 + r) * QKVW + head * 64 + 8 * h;
#pragma unroll
          for (int ks = 0; ks < 4; ++ks) qf[ks] = *(const bf16x8*)(qp + 16 * ks); }
        __syncthreads();
#pragma unroll 1
        for (int qt = 0; qt < 4; ++qt) {
            const size_t qrow = (size_t)b * SEQ + nb * 128 + 32 * qt + r;
            bf16x8 qn[4];
            { const bf16* qp = QKV + (qrow + (qt < 3 ? 32 : 0)) * QKVW + head * 64 + 8 * h;
#pragma unroll
              for (int ks = 0; ks < 4; ++ks) qn[ks] = *(const bf16x8*)(qp + 16 * ks); }
            f32x16 S[5];
            float m = sink2;
#pragma unroll
            for (int e = 0; e < 5; ++e) {
                const int kb = qt + e;
                if (nb > 0 || kb >= 4) {
                    f32x16 acc;
#pragma unroll
                    for (int i = 0; i < 16; ++i) acc[i] = 0.f;
#pragma unroll
                    for (int ks = 0; ks < 4; ++ks) { const bf16x8 a = *(const LAS bf16x8*)(Ks + (32 * kb + r) * AT_KSTR + (16 * ks + 8 * h) * 2); acc = MFMA32(a, qf[ks], acc); }
#pragma unroll
                    for (int i = 0; i < 16; ++i) { const float s = acc[i] * SC + tb[160 - 32 * e + r - crow16(i, h)]; S[e][i] = s; m = fmaxf(m, s); }
                } else {
#pragma unroll
                    for (int i = 0; i < 16; ++i) S[e][i] = -1e30f;
                }
            }
            m = fmaxf(m, __shfl_xor(m, 32));
            float l = 0.f;
#pragma unroll
            for (int e = 0; e < 5; ++e)
#pragma unroll
                for (int i = 0; i < 16; ++i) { const float p = __builtin_amdgcn_exp2f(S[e][i] - m); S[e][i] = p; l += p; }
            l += __shfl_xor(l, 32);
            l += __builtin_amdgcn_exp2f(sink2 - m);
            f32x16 O0, O1;
#pragma unroll
            for (int i = 0; i < 16; ++i) { O0[i] = 0.f; O1[i] = 0.f; }
#pragma unroll
            for (int e = 0; e < 5; ++e) {
                const int kb = qt + e;
                if (nb > 0 || kb >= 4) {
#pragma unroll
                    for (int s = 0; s < 2; ++s) {
                        v4u pw; pw.x = cvtpk(S[e][8 * s], S[e][8 * s + 1]); pw.y = cvtpk(S[e][8 * s + 2], S[e][8 * s + 3]); pw.z = cvtpk(S[e][8 * s + 4], S[e][8 * s + 5]); pw.w = cvtpk(S[e][8 * s + 6], S[e][8 * s + 7]);
                        const bf16x8 pb = __builtin_bit_cast(bf16x8, pw);
                        const LAS unsigned char* vb = Vt + r * AT_VSTR + (32 * kb + 16 * s + 4 * h) * 2;
                        { const v2u lo = *(const LAS v2u*)vb, hi = *(const LAS v2u*)(vb + 16); v4u aw; aw.x = lo.x; aw.y = lo.y; aw.z = hi.x; aw.w = hi.y; O0 = MFMA32(__builtin_bit_cast(bf16x8, aw), pb, O0); }
                        { const v2u lo = *(const LAS v2u*)(vb + 32 * AT_VSTR), hi = *(const LAS v2u*)(vb + 32 * AT_VSTR + 16); v4u aw; aw.x = lo.x; aw.y = lo.y; aw.z = hi.x; aw.w = hi.y; O1 = MFMA32(__builtin_bit_cast(bf16x8, aw), pb, O1); }
                    }
                }
            }
            const float inv = 1.0f / l;
            bf16* op = AO + qrow * LDX + head * 64 + 4 * h;
#pragma unroll
            for (int i4 = 0; i4 < 4; ++i4) {
                v2u o; o.x = cvtpk(O0[4 * i4] * inv, O0[4 * i4 + 1] * inv); o.y = cvtpk(O0[4 * i4 + 2] * inv, O0[4 * i4 + 3] * inv); *(v2u*)(op + 8 * i4) = o;
                o.x = cvtpk(O1[4 * i4] * inv, O1[4 * i4 + 1] * inv); o.y = cvtpk(O1[4 * i4 + 2] * inv, O1[4 * i4 + 3] * inv); *(v2u*)(op + 32 + 8 * i4) = o;
            }
#pragma unroll
            for (int ks = 0; ks < 4; ++ks) qf[ks] = qn[ks];
        }
        __syncthreads();
    }
}
__device__ __forceinline__ float gelu_tanh(float x) {
    const float z = 0.7978845608028654f * (x + 0.044715f * x * x * x);
    return x * __builtin_amdgcn_rcpf(1.0f + __builtin_amdgcn_exp2f(-2.0f * 1.4426950408889634f * z));
}
constexpr int S5_KT_ELEMS = 33 * 256, S5_BE_ELEMS = 128 * 512, S5_CP_ELEMS = 512 * 128;
constexpr int S5_XE_STRIDE = 132;
constexpr int S5_LDS_XE = 0, S5_LDS_KT = 128 * S5_XE_STRIDE * 4;
static_assert(S5_LDS_KT + S5_KT_ELEMS * 2 <= RING_BYTES, "S5 LDS map");

__device__ __forceinline__ void s5_tables(Frame& F, const float* lam_re, const float* lam_im, const float* log_step, const float* b_re, const float* b_im,
                                          const float* c_re, const float* c_im, bf16* KT, bf16* BE, bf16* CP, float* AT, int g0, int gstep) {
    LAS float* apr = (LAS float*)(F.lds); LAS float* api = apr + 33 * 64; LAS float* Cr = api + 33 * 64; LAS float* Ci = Cr + 1024; LAS float* Br = Ci + 1024; LAS float* Bi = Br + 64 * 17;
    LAS float* ffr = Bi + 64 * 17; LAS float* ffi = ffr + 64;
    const int tid = F.tid;
    for (int g = g0; g < SG; g += gstep) {
        const float delta = expf(log_step[g]);
        for (int e = tid; e < 33 * 64; e += NWAVES * 64) { const int tau = e >> 6, p = e & 63; const float lr = lam_re[g * SP + p], li = lam_im[g * SP + p];
            double ang = (double)li * (double)delta * (double)tau; ang -= 6.283185307179586 * rint(ang * 0.15915494309189535);
            float sn, cs; sincosf((float)ang, &sn, &cs); const float mag = expf(lr * delta * (float)tau); apr[p * 33 + tau] = mag * cs; api[p * 33 + tau] = mag * sn; }
        for (int e = tid; e < 1024; e += NWAVES * 64) { const int c = e >> 6, p = e & 63; Cr[p * 16 + c] = c_re[(size_t)g * 1024 + e]; Ci[p * 16 + c] = c_im[(size_t)g * 1024 + e]; }
        if (tid < 64) { const int p = tid; const float lr = lam_re[g * SP + p], li = lam_im[g * SP + p];
            double ang = (double)li * (double)delta; ang -= 6.283185307179586 * rint(ang * 0.15915494309189535);
            const float y = (float)ang, x = lr * delta; float sn, cs, sh, ch; sincosf(y, &sn, &cs); sincosf(0.5f * y, &sh, &ch);
            const float em1 = expm1f(x); const float nr = em1 * cs - 2.0f * sh * sh, ni = (em1 + 1.0f) * sn, den = lr * lr + li * li;
            ffr[p] = (nr * lr + ni * li) / den; ffi[p] = (ni * lr - nr * li) / den; }
        __syncthreads();
        for (int e = tid; e < 1024; e += NWAVES * 64) { const int p = e >> 4; const float Bre = b_re[(size_t)g * 1024 + e], Bim = b_im[(size_t)g * 1024 + e], fr = ffr[p], fi = ffi[p];
            Br[p * 17 + (e & 15)] = fr * Bre - fi * Bim; Bi[p * 17 + (e & 15)] = fr * Bim + fi * Bre; }
        __syncthreads();
        {
            const int tau = tid >> 4, c = tid & 15; float acc[16];
#pragma unroll
            for (int cc = 0; cc < 16; ++cc) acc[cc] = 0.f;
            for (int p = 0; p < 64; ++p) { const float cr = Cr[p * 16 + c], ci = Ci[p * 16 + c], pr = apr[p * 33 + tau], pi = api[p * 33 + tau];
                const float er = cr * pr - ci * pi, ei = cr * pi + ci * pr;
#pragma unroll
                for (int cc = 0; cc < 16; ++cc) acc[cc] += er * Br[p * 17 + cc] - ei * Bi[p * 17 + cc]; }
            v4u o0, o1; o0.x = pk2(acc[0], acc[1]); o0.y = pk2(acc[2], acc[3]); o0.z = pk2(acc[4], acc[5]); o0.w = pk2(acc[6], acc[7]);
            o1.x = pk2(acc[8], acc[9]); o1.y = pk2(acc[10], acc[11]); o1.z = pk2(acc[12], acc[13]); o1.w = pk2(acc[14], acc[15]);
            v4u* dst = (v4u*)(KT + (size_t)g * S5_KT_ELEMS + (tau + 1) * 256 + c * 16); dst[0] = o0; dst[1] = o1;
            if (tid < 16) { v4u* z = (v4u*)(KT + (size_t)g * S5_KT_ELEMS + tid * 16); const v4u zz = {0u, 0u, 0u, 0u}; z[0] = zz; z[1] = zz; }
        }
        {
            const int pp = tid >> 2, sq = tid & 3, p = pp & 63; const bool im = pp >= 64;
            for (int s = 8 * sq; s < 8 * sq + 8; ++s) { const float pr = apr[p * 33 + (31 - s)], pi = api[p * 33 + (31 - s)]; float v[16];
#pragma unroll
                for (int cc = 0; cc < 16; ++cc) { const float br = Br[p * 17 + cc], bi = Bi[p * 17 + cc]; v[cc] = im ? (pr * bi + pi * br) : (pr * br - pi * bi); }
                v4u o0, o1; o0.x = pk2(v[0], v[1]); o0.y = pk2(v[2], v[3]); o0.z = pk2(v[4], v[5]); o0.w = pk2(v[6], v[7]);
                o1.x = pk2(v[8], v[9]); o1.y = pk2(v[10], v[11]); o1.z = pk2(v[12], v[13]); o1.w = pk2(v[14], v[15]);
                v4u* dst = (v4u*)(BE + (size_t)g * S5_BE_ELEMS + (size_t)pp * 512 + s * 16); dst[0] = o0; dst[1] = o1; }
        }
        {
            const int t = tid >> 4, c = tid & 15; bf16* dst = CP + (size_t)g * S5_CP_ELEMS + (size_t)tid * 128;
            for (int p0 = 0; p0 < 64; p0 += 8) { float er[8], ei[8];
#pragma unroll
                for (int j = 0; j < 8; ++j) { const int p = p0 + j; const float cr = Cr[p * 16 + c], ci = Ci[p * 16 + c], pr = apr[p * 33 + t + 1], pi = api[p * 33 + t + 1];
                    er[j] = cr * pr - ci * pi; ei[j] = -(cr * pi + ci * pr); }
                v4u o; o.x = pk2(er[0], er[1]); o.y = pk2(er[2], er[3]); o.z = pk2(er[4], er[5]); o.w = pk2(er[6], er[7]); *(v4u*)(dst + p0) = o;
                o.x = pk2(ei[0], ei[1]); o.y = pk2(ei[2], ei[3]); o.z = pk2(ei[4], ei[5]); o.w = pk2(ei[6], ei[7]); *(v4u*)(dst + 64 + p0) = o; }
        }
        if (tid < 64) { AT[(size_t)g * 128 + tid * 2] = apr[tid * 33 + 32]; AT[(size_t)g * 128 + tid * 2 + 1] = api[tid * 33 + 32]; }
        __syncthreads();
    }
}

__device__ __forceinline__ bf16x8 pack8(const f32x4 lo, const f32x4 hi) {
    v4u w; w.x = pg8::cvt_pk_bf16(lo[0], lo[1]); w.y = pg8::cvt_pk_bf16(lo[2], lo[3]); w.z = pg8::cvt_pk_bf16(hi[0], hi[1]); w.w = pg8::cvt_pk_bf16(hi[2], hi[3]);
    return __builtin_bit_cast(bf16x8, w);
}
constexpr int S5_US_STRIDE = 1056;
constexpr int S5_LDS_US = S5_LDS_KT + S5_KT_ELEMS * 2;
static_assert(S5_LDS_US % 16 == 0 && S5_LDS_US + 32 * S5_US_STRIDE <= RING_BYTES, "S5 LDS map");
__device__ __forceinline__ void s5_mixer(Frame& F, const ssq_t* ss, const float* gain, const bf16* HS, const bf16* KT, const bf16* BE, const bf16* CP, const float* AT, const float* d_skip, bf16* YG) {
    LAS float* XE = (LAS float*)(F.lds + S5_LDS_XE);
    LAS unsigned char* KTl = F.lds + S5_LDS_KT;
    LAS unsigned char* US = F.lds + S5_LDS_US;
    const int lane = F.lane, r = lane & 31, h = lane >> 5, w = F.wave;
    for (int u = F.vcu; u < 2 * SG; u += F.G) {
        const int g = u & (SG - 1), b = u >> 8;
        const bf16* Hs = HS + (size_t)u * SEQ * SGC;
        const v4u* slab4 = (const v4u*)Hs;
        int sdst[4];
#pragma unroll
        for (int i = 0; i < 4; ++i) { const int q = F.tid + 512 * i, tok = q >> 1; sdst[i] = (tok >> 5) * S5_US_STRIDE + (tok & 31) * 32 + (q & 1) * 16; }
        float gn[8];
#pragma unroll
        for (int c = 0; c < 8; ++c) gn[c] = gain[g * SGC + 8 * (F.tid & 1) + c];
        const ssq_t* ssb = ss + (size_t)b * SEQ;
#define S5_STAGE_LOAD(nb_) do { _Pragma("unroll") for (int i = 0; i < 4; ++i) { st[i] = slab4[(nb_) * 2048 + F.tid + 512 * i]; sv[i] = ss_get(ssb, (nb_) * 1024 + ((F.tid + 512 * i) >> 1)); } } while (0)
#define S5_STAGE_STORE() do { _Pragma("unroll") for (int i = 0; i < 4; ++i) { const float rs = __builtin_amdgcn_rsqf(sv[i] * (1.0f / DM) + EPS); v4u o; \
            o.x = pk2(xlo(st[i].x) * rs * gn[0], xhi(st[i].x) * rs * gn[1]); o.y = pk2(xlo(st[i].y) * rs * gn[2], xhi(st[i].y) * rs * gn[3]); \
            o.z = pk2(xlo(st[i].z) * rs * gn[4], xhi(st[i].z) * rs * gn[5]); o.w = pk2(xlo(st[i].w) * rs * gn[6], xhi(st[i].w) * rs * gn[7]); \
            *(LAS v4u*)(US + sdst[i]) = o; } } while (0)
        const LAS unsigned char* ufrag = US + r * S5_US_STRIDE + 16 * h;
        { const v4u* src = (const v4u*)(KT + (size_t)g * S5_KT_ELEMS); LAS v4u* dst = (LAS v4u*)KTl; for (int e = F.tid; e < S5_KT_ELEMS * 2 / 16; e += NWAVES * 64) dst[e] = src[e];
 }
        __syncthreads();
        {
            const int mb = w & 3, sh = w >> 2;
            bf16x8 ber[16];
            { const bf16* BEb = BE + (size_t)g * S5_BE_ELEMS + (size_t)(32 * mb + r) * 512 + (16 * sh) * 16 + 8 * h;
#pragma unroll
              for (int si = 0; si < 16; ++si) ber[si] = *(const bf16x8*)(BEb + si * 16); }
            v4u st[4]; float sv[4];
            S5_STAGE_LOAD(0);
#pragma unroll 1
            for (int nb = 0; nb < 4; ++nb) {
                S5_STAGE_STORE();
                __syncthreads();
                if (nb < 3) S5_STAGE_LOAD(nb + 1);
                f32x16 acc0, acc1;
#pragma unroll
                for (int i = 0; i < 16; ++i) { acc0[i] = 0.f; acc1[i] = 0.f; }
#pragma unroll
                for (int si = 0; si < 16; si += 2) { const bf16x8 u0 = *(const LAS bf16x8*)(ufrag + (16 * sh + si) * 32), u1 = *(const LAS bf16x8*)(ufrag + (16 * sh + si + 1) * 32);
                    acc0 = MFMA32(ber[si], u0, acc0); acc1 = MFMA32(ber[si + 1], u1, acc1); }
                LAS float* xrow = XE + (32 * nb + r) * S5_XE_STRIDE + 32 * mb + 4 * h;
                if (sh == 0) {
#pragma unroll
                    for (int i4 = 0; i4 < 4; ++i4) *(LAS f32x4*)(xrow + 8 * i4) = (f32x4){acc0[4 * i4] + acc1[4 * i4], acc0[4 * i4 + 1] + acc1[4 * i4 + 1], acc0[4 * i4 + 2] + acc1[4 * i4 + 2], acc0[4 * i4 + 3] + acc1[4 * i4 + 3]};
                }
                __syncthreads();
                if (sh == 1) {
#pragma unroll
                    for (int i4 = 0; i4 < 4; ++i4) { const f32x4 o = *(const LAS f32x4*)(xrow + 8 * i4);
                        *(LAS f32x4*)(xrow + 8 * i4) = (f32x4){o[0] + acc0[4 * i4] + acc1[4 * i4], o[1] + acc0[4 * i4 + 1] + acc1[4 * i4 + 1], o[2] + acc0[4 * i4 + 2] + acc1[4 * i4 + 2], o[3] + acc0[4 * i4 + 3] + acc1[4 * i4 + 3]}; }
                }
            }
            __syncthreads();
        }
        if (w == 0) {
            const float atr = AT[(size_t)g * 128 + lane * 2], ati = AT[(size_t)g * 128 + lane * 2 + 1];
            float xr = 0.f, xi = 0.f;
            for (int k0 = 0; k0 < 127; k0 += 8) {
                float er[8], ei[8];
#pragma unroll
                for (int i = 0; i < 8; ++i) if (k0 + i < 127) { er[i] = XE[(k0 + i) * S5_XE_STRIDE + lane]; ei[i] = XE[(k0 + i) * S5_XE_STRIDE + 64 + lane]; }
#pragma unroll
                for (int i = 0; i < 8; ++i) if (k0 + i < 127) { const float nxr = atr * xr - ati * xi + er[i], nxi = atr * xi + ati * xr + ei[i]; xr = nxr; xi = nxi; er[i] = xr; ei[i] = xi; }
#pragma unroll
                for (int i = 0; i < 8; ++i) if (k0 + i < 127) { XE[(k0 + i) * S5_XE_STRIDE + lane] = er[i]; XE[(k0 + i) * S5_XE_STRIDE + 64 + lane] = ei[i]; }
            }
        }
        {
            const int jA = w, jB = 15 - w;
            bf16x8 cpa[8], cpb[8];
            { const bf16* CPg = CP + (size_t)g * S5_CP_ELEMS + (size_t)r * 128 + 8 * h;
#pragma unroll
              for (int ks = 0; ks < 8; ++ks) { cpa[ks] = *(const bf16x8*)(CPg + (size_t)(32 * jA) * 128 + 16 * ks); cpb[ks] = *(const bf16x8*)(CPg + (size_t)(32 * jB) * 128 + 16 * ks); } }
            const f32x4 dsk0 = *(const f32x4*)(d_skip + g * SGC + 4 * h), dsk1 = *(const f32x4*)(d_skip + g * SGC + 8 + 4 * h);
            const int ktl = ((r >> 4) * 256 + (r & 15) * 16 + 8 * h) * 2;
            v4u st[4]; float sv[4];
            S5_STAGE_LOAD(0);
            __syncthreads();
            {
#pragma unroll 1
            for (int nb = 0; nb < 4; ++nb) {
                S5_STAGE_STORE();
                __syncthreads();
                if (nb < 3) S5_STAGE_LOAD(nb + 1);
                const int kc = 32 * nb + r;
                f32x16 cA, cB;
#pragma unroll
                for (int i = 0; i < 16; ++i) { cA[i] = 0.f; cB[i] = 0.f; }
#pragma unroll
                for (int ks = 0; ks < 8; ++ks) {
                    f32x4 lo = {0.f, 0.f, 0.f, 0.f}, hi = {0.f, 0.f, 0.f, 0.f};
                    if (kc >= 1) { const LAS float* xp = XE + (kc - 1) * S5_XE_STRIDE + 16 * ks + 8 * h; lo = *(const LAS f32x4*)xp; hi = *(const LAS f32x4*)(xp + 4); }
                    const bf16x8 xb = pack8(lo, hi);
                    cA = MFMA32(cpa[ks], xb, cA); cB = MFMA32(cpb[ks], xb, cB);
                }
                const int nA = 2 * jA + 2, nB = 2 * jB + 2;
                const LAS unsigned char* ka = KTl + ktl + (2 * jA + 1) * 512; const LAS unsigned char* kb = KTl + ktl + (2 * jB + 1) * 512;
                {
#define S5_U(s_) (*(const LAS bf16x8*)(ufrag + (s_) * 32))
#define S5_KA(s_) (*(const LAS bf16x8*)(ka - (s_) * 512))
#define S5_KB(s_) (*(const LAS bf16x8*)(kb - (s_) * 512))
                    bf16x8 u0 = S5_U(0), u1 = S5_U(1), a0 = S5_KA(0), a1 = S5_KA(1), b0 = S5_KB(0), b1 = S5_KB(1);
#pragma unroll 1
                    for (int s = 0; s < nA; s += 2) {
                        const bf16x8 nu0 = S5_U(s + 2), nu1 = S5_U(s + 3), na0 = S5_KA(s + 2), na1 = S5_KA(s + 3), nb0 = S5_KB(s + 2), nb1 = S5_KB(s + 3);
                        cA = MFMA32(a0, u0, cA); cB = MFMA32(b0, u0, cB); cA = MFMA32(a1, u1, cA); cB = MFMA32(b1, u1, cB);
                        u0 = nu0; u1 = nu1; a0 = na0; a1 = na1; b0 = nb0; b1 = nb1;
                    }
#pragma unroll 1
                    for (int s = nA; s < nB; s += 2) {
                        const bf16x8 nu0 = S5_U(s + 2), nu1 = S5_U(s + 3), nb0 = S5_KB(s + 2), nb1 = S5_KB(s + 3);
                        cB = MFMA32(b0, u0, cB); cB = MFMA32(b1, u1, cB);
                        u0 = nu0; u1 = nu1; b0 = nb0; b1 = nb1;
                    }
#undef S5_U
#undef S5_KA
#undef S5_KB
                }
#define S5_EPI(cacc, jj) do { _Pragma("unroll") for (int i4 = 0; i4 < 4; ++i4) { \
                    const int t = 2 * (jj) + (i4 >> 1), c0i = 8 * (i4 & 1) + 4 * h; const size_t off = ((size_t)(b * SEQ + kc * 32 + t)) * LDX + g * SGC + c0i; \
                    const v2u uw = *(const LAS v2u*)(US + r * S5_US_STRIDE + t * 32 + c0i * 2); const f32x4 dk = (i4 & 1) ? dsk1 : dsk0; \
                    const float y0 = cacc[4 * i4] + dk[0] * bf_lo(uw.x), y1 = cacc[4 * i4 + 1] + dk[1] * bf_hi(uw.x), y2 = cacc[4 * i4 + 2] + dk[2] * bf_lo(uw.y), y3 = cacc[4 * i4 + 3] + dk[3] * bf_hi(uw.y); \
                    v2u ow; ow.x = pg8::cvt_pk_bf16(gelu_tanh(y0), gelu_tanh(y1)); ow.y = pg8::cvt_pk_bf16(gelu_tanh(y2), gelu_tanh(y3)); *(v2u*)(YG + off) = ow; } } while (0)
                S5_EPI(cA, jA); S5_EPI(cB, jB);
#undef S5_EPI
                __syncthreads();
            }
            }
        }
#undef S5_STAGE_LOAD
#undef S5_STAGE_STORE
    }
}
__device__ __forceinline__ void conv_fixup(Frame& F, const float* HEAD, const float* TAIL, const float* cw, const float* cb, bf16* ACT, const float* wsc) {
    const int gt = F.vcu * NWAVES * 64 + F.tid, NGT = F.G * NWAVES * 64;
    for (int it = gt; it < (M / 256) * FF; it += NGT) {
        const int blk = it / FF, f = it - blk * FF;
        const int nn = ((f >> 7) << 8) + (f & 127);
        float c0[2], c1[2];
#pragma unroll
        for (int bj = 0; bj < 2; ++bj) {
            const int col = bj * FF + f, nc = nn + bj * 128;
            const float sc = wsc ? wsc[nc] : 1.0f; const float w0 = cw[col] * sc, w1 = cw[NUP + col] * sc, w2 = cw[2 * NUP + col] * sc, bb = cb[col];
            float t0 = 0.f, t1 = 0.f;
            if ((blk & 15) != 0) {
            t0 = TAIL[((size_t)(blk - 1) * 2 + 0) * NUP + nc]; t1 = TAIL[((size_t)(blk - 1) * 2 + 1) * NUP + nc]; }
            const float h0 = HEAD[((size_t)blk * 2 + 0) * NUP + nc], h1 = HEAD[((size_t)blk * 2 + 1) * NUP + nc];
            c0[bj] = bb + w0 * t0 + w1 * t1 + w2 * h0;
            c1[bj] = bb + w0 * t1 + w1 * h0 + w2 * h1;
        }
        const float o0 = c0[0] * pg8::fast_sigmoid(c0[0]) * c0[1], o1 = c1[0] * pg8::fast_sigmoid(c1[0]) * c1[1];
        ACT[(size_t)(blk * 256) * LDACT + f] = (bf16)f2bf(o0);
        ACT[(size_t)(blk * 256 + 1) * LDACT + f] = (bf16)f2bf(o1);
    }
}

struct Args { const float* in[22]; float* out; unsigned char* ws; int ph_lo, ph_hi, li, pad; };
__global__ void __launch_bounds__(NWAVES * 64, 2) mk_fwd(Args args) {
    extern __shared__ __attribute__((aligned(16))) unsigned char lds[];
    Frame F;
    F.lds = (LAS unsigned char*)lds;
    F.MISC = (volatile LAS unsigned*)(F.lds + MISC_OFF);
    F.tid = threadIdx.x; F.lane = F.tid & 63; F.wave = __builtin_amdgcn_readfirstlane(F.tid >> 6);
    F.G = gridDim.x; { const int bx = blockIdx.x; F.vcu = (F.G % 8 == 0) ? (bx % 8) * (F.G / 8) + bx / 8 : bx; }
    unsigned char* ws = args.ws;
    F.ctl = (gu32*)(ws + WS_CTL);
    for (int u = F.tid; u < (LDS_BYTES - LDSCTL_OFF) / 4; u += NWAVES * 64) ((LAS unsigned*)(F.lds + LDSCTL_OFF))[u] = 0u;
    __syncthreads();
    XcdBarrier bar; bar.bar = (unsigned*)(F.ctl + CW_BAR); bar.x = 0; bar.st = nullptr;
    if (N_LAUNCHES == 1) bar = xcd_barrier_post((unsigned*)(F.ctl + CW_BAR), F.MISC + 8);
#define GRID_BAR() do { if (N_LAUNCHES == 1) xcd_barrier(bar); } while (0)
    const int lo = args.ph_lo, hi = args.ph_hi;
#define IN(k) (lo <= (k) && (k) < hi)
#define BOTH(k) (IN(k) && IN((k) + 1))
    const float* x_in = args.in[0];
    float* X = (float*)(ws + WS_X);
    bf16* XNB = (bf16*)(ws + WS_XNB);
    bf16* XN = (bf16*)(ws + WS_XN); bf16* QKV = (bf16*)(ws + WS_QKV); bf16* AO = (bf16*)(ws + WS_AO); bf16* ACT = (bf16*)(ws + WS_ACT);
    float* HEAD = (float*)(ws + WS_HEAD); float* TAIL = (float*)(ws + WS_TAIL);

    ssq_t* SS0 = (ssq_t*)(ws + WS_SS); ssq_t* SS1 = SS0 + M; ssq_t* SS2 = SS1 + M; ssq_t* SS3 = SS2 + M; ssq_t* SS4 = SS3 + M;
    const float INVD = 1.0f / DM;
    LAS float* TLX = (LAS float*)(F.lds + LDSCTL_OFF + 1024);
#ifndef CVT_P0
#define CVT_P0 10240
#endif
    static_assert(CVT_P0 >= CI_QKV && CVT_P0 <= CVT_ITEMS, "prologue share");
    const bool split = (F.G == 256);
    const bool defer = false;
    if (IN(0)) { if (!split) s5_tables(F, args.in[7], args.in[8], args.in[9], args.in[10], args.in[11], args.in[12], args.in[13], (bf16*)(ws + WS_S5KT), (bf16*)(ws + WS_S5BE), (bf16*)(ws + WS_S5CP), (float*)(ws + WS_S5AT), (int)blockIdx.x, F.G);
        convert_weights(F, args.in, ws, 0, split ? CVT_P0 : (defer ? CVT_NP : CVT_ITEMS), F.vcu * NWAVES + F.wave, F.G * NWAVES); if (!split) convert_panels(F, args.in, ws, 0, NPAN, (int)blockIdx.x, F.G); x0_rows(F, x_in, XN, XNB, SS0); if (BOTH(0)) GRID_BAR(); }
    if (IN(1)) { pg8::Gemm g{XNB, (const bf16*)(ws + WS_WQKV), M, QKVW, DM, LDX, LDW}; pg8::StaticOrder S;
#ifndef QKV_WGS
#define QKV_WGS 128
#endif
        const bool gemm_side = !split || (int)blockIdx.x < QKV_WGS;
        if (split) S.init(M, QKVW, QKV_WGS, (int)blockIdx.x); else S.init(M, QKVW, F.G, (int)blockIdx.x);
        pg8::EpiBf16Scale E{QKV, QKVW, pg8::RowScale{SS0, nullptr, INVD, EPS}};
#ifndef CVT_GSIDE
#define CVT_GSIDE 12288
#endif
#ifndef CVT_T4
#define CVT_T4 14336
#define CVT_T9 7168
#endif
        constexpr int CVT_TAIL = CVT_T4 + CVT_T9;
        static_assert(CVT_TAIL <= CI_DN && CVT_TAIL + CVT_GSIDE + CVT_P0 <= CVT_ITEMS, "deferred conversion items");
        const int cvt_tail = split ? CVT_TAIL : 0;
        if (gemm_side) { pg8::gemm_phase<pg8::EpiBf16Scale, pg8::StaticOrder, true, true>(F.lds + RING_OFF, g, S, E);
            if (split) convert_weights(F, args.in, ws, CVT_ITEMS - CVT_TAIL - CVT_GSIDE, CVT_GSIDE, (int)blockIdx.x * NWAVES + F.wave, QKV_WGS * NWAVES); }
        else { s5_tables(F, args.in[7], args.in[8], args.in[9], args.in[10], args.in[11], args.in[12], args.in[13], (bf16*)(ws + WS_S5KT), (bf16*)(ws + WS_S5BE), (bf16*)(ws + WS_S5CP), (float*)(ws + WS_S5AT), (int)blockIdx.x - QKV_WGS, 256 - QKV_WGS);
            convert_weights(F, args.in, ws, CVT_P0, CVT_ITEMS - CVT_P0 - CVT_GSIDE - cvt_tail, ((int)blockIdx.x - QKV_WGS) * NWAVES + F.wave, (256 - QKV_WGS) * NWAVES);
            convert_panels(F, args.in, ws, 0, NPAN, (int)blockIdx.x - QKV_WGS, 256 - QKV_WGS); }
        if (defer && blockIdx.x >= 128) convert_weights(F, args.in, ws, CVT_NP, CVT_N1, ((int)blockIdx.x - 128) * NWAVES + F.wave, CVT_W1);
        if (BOTH(1)) GRID_BAR(); }
    if (IN(2)) { attn_mfma(F, QKV, args.in[4], args.in[5], AO);
        for (int i = NI8 + (int)blockIdx.x * 512 + F.tid; i < NUP; i += F.G * 512) ((float*)(ws + WS_WSC0))[i] = 1.0f;
        if (BOTH(2)) GRID_BAR(); }
    if (IN(3)) { pg8::Gemm g{AO, (const bf16*)(ws + WS_WO), M, DM, DM, LDX, LDW}; pg8::StaticOrder S; S.init(M, DM, F.G, (int)blockIdx.x);
        pg8::EpiRes<false, false> E{XN, LDX, XN, LDX, SS1, nullptr, XNB};
        pg8::gemm_phase<pg8::EpiRes<false, false>, pg8::StaticOrder, true, true>(F.lds + RING_OFF, g, S, E);
        if (BOTH(3)) GRID_BAR(); }
    if (IN(4)) { quant_rows<true>(F, XN, 0, M, LDX, ws + WS_XQ, (float*)(ws + WS_ASC), SS1, F.vcu * NWAVES + F.wave, F.G * NWAVES); GRID_BAR();
        { pg8::Gemm g{(const bf16*)(ws + WS_XQ), (const bf16*)(ws + WS_WQ0), M, NI8, DM / 2, LDQ / 2, LDQ / 2}; pg8::StaticOrder S; S.init(M, NI8, F.G, (int)blockIdx.x);
          pg8::EpiConvGate E{ACT, LDACT, HEAD, TAIL, args.in[18], args.in[19], FF, NUP, pg8::RowScale{nullptr, (const float*)(ws + WS_ASC), 0.f, 0.f}, TLX, (const float*)(ws + WS_WSC0)};
          pg8::gemm_phase_i8<pg8::EpiConvGate, pg8::StaticOrder, true, true>(F.lds + RING_OFF, g, S, E); }
        __syncthreads();
        int tz; asm volatile("s_mov_b32 %0, 0" : "=s"(tz));
        { pg8::Gemm g{XNB, (const bf16*)(ws + WS_WUP0) + (size_t)NI8 * LDW, M, NUP - NI8, DM, LDX, LDW}; pg8::StaticOrder S; S.init(M, NUP - NI8, F.G, (int)blockIdx.x);
          pg8::EpiConvGate E{ACT + NI8 / 2, LDACT, HEAD + NI8, TAIL + NI8, args.in[18] + NI8 / 2, args.in[19] + NI8 / 2, FF, NUP, pg8::RowScale{SS1, nullptr, INVD, EPS}, TLX, nullptr};
          pg8::gemm_phase<pg8::EpiConvGate, pg8::StaticOrder, true, true>(F.lds + RING_OFF, g, S, E, tz); }
        if (split && blockIdx.x >= 192) { __syncthreads(); convert_weights(F, args.in, ws, CVT_ITEMS - CVT_T4 - CVT_T9, CVT_T4, ((int)blockIdx.x - 192) * NWAVES + F.wave, 64 * NWAVES); }
        if (BOTH(4)) GRID_BAR(); }
    if (IN(5)) { conv_fixup(F, HEAD, TAIL, args.in[18], args.in[19], ACT, (const float*)(ws + WS_WSC0));
        if (BOTH(5)) GRID_BAR(); }
    if (IN(6)) { pg8::Gemm g{ACT, (const bf16*)(ws + WS_WDN0), M, DM, FF, LDACT, LDWF}; pg8::StaticOrder S; S.init(M, DM, F.G, (int)blockIdx.x);
        pg8::EpiRes<false, false> E{XN, LDX, XN, LDX, SS2, (bf16*)(ws + WS_S5H), nullptr};
        pg8::gemm_phase<pg8::EpiRes<false, false>, pg8::StaticOrder, true, true>(F.lds + RING_OFF, g, S, E);
        if (BOTH(6)) GRID_BAR(); }
    if (IN(7)) { s5_mixer(F, SS2, args.in[6], (const bf16*)(ws + WS_S5H), (const bf16*)(ws + WS_S5KT), (const bf16*)(ws + WS_S5BE), (const bf16*)(ws + WS_S5CP), (const float*)(ws + WS_S5AT), args.in[14], AO);
        if (BOTH(7)) GRID_BAR(); }
    if (IN(8)) { pg8::Gemm g{AO, (const bf16*)(ws + WS_WGLU), M, 2 * DM, DM, LDX, LDW}; pg8::StaticOrder S; S.init(M, 2 * DM, F.G, (int)blockIdx.x);
        pg8::EpiGluRes E{XN, LDX, SS3};
        pg8::gemm_phase<pg8::EpiGluRes, pg8::StaticOrder, true, true>(F.lds + RING_OFF, g, S, E);
        if (BOTH(8)) GRID_BAR(); }
    if (IN(9)) { quant_rows<true>(F, XN, 0, M, LDX, ws + WS_XQ, (float*)(ws + WS_ASC), SS3, F.vcu * NWAVES + F.wave, F.G * NWAVES); GRID_BAR();
        pg8::Gemm g{(const bf16*)(ws + WS_XQ), (const bf16*)(ws + WS_WQ1), M, NUP, DM / 2, LDQ / 2, LDQ / 2}; pg8::StaticOrder S; S.init(M, NUP, F.G, (int)blockIdx.x);
        pg8::EpiConvGate E{ACT, LDACT, HEAD, TAIL, args.in[18] + 3 * NUP, args.in[19] + NUP, FF, NUP, pg8::RowScale{nullptr, (const float*)(ws + WS_ASC), 0.f, 0.f}, TLX, (const float*)(ws + WS_WSC1)};
        pg8::gemm_phase_i8<pg8::EpiConvGate, pg8::StaticOrder, true, true>(F.lds + RING_OFF, g, S, E);
        if (split && blockIdx.x >= 192) { __syncthreads(); convert_weights(F, args.in, ws, CVT_ITEMS - CVT_T9, CVT_T9, ((int)blockIdx.x - 192) * NWAVES + F.wave, 64 * NWAVES); }
        if (BOTH(9)) GRID_BAR(); }
    if (IN(10)) { conv_fixup(F, HEAD, TAIL, args.in[18] + 3 * NUP, args.in[19] + NUP, ACT, (const float*)(ws + WS_WSC1)); if (BOTH(10)) GRID_BAR(); }
    if (IN(11)) { pg8::Gemm g{ACT, (const bf16*)(ws + WS_WDN1), M, DM, FF, LDACT, LDWF}; pg8::StaticOrder S; S.init(M, DM, F.G, (int)blockIdx.x);
        pg8::EpiRes<false, false> E{XN, LDX, XN, LDX, SS4, nullptr, nullptr};
        pg8::gemm_phase<pg8::EpiRes<false, false>, pg8::StaticOrder, true, true>(F.lds + RING_OFF, g, S, E);
        if (BOTH(11)) GRID_BAR(); }
    if (IN(12)) { final_rows(F, XN, SS4, args.in[21], args.out); }
#undef IN
#undef BOTH
}

extern "C" void kernel_launch(void* const* d_in, const int* in_sizes, int n_in, void* d_out, int out_size, void* d_ws, size_t ws_size, hipStream_t stream) {
    static int grid = 0;
    if (grid == 0) {
        if (n_in != 22 || out_size != M * DM || ws_size < WS_END) { fprintf(stderr, "kernel_launch: unexpected shapes (n_in %d, out %d, ws %zu < %zu)\n", n_in, out_size, ws_size, (size_t)WS_END); grid = -1; return; }
        int dev = 0, cus = 0, per_cu = 0;
        if (hipGetDevice(&dev) != hipSuccess || hipDeviceGetAttribute(&cus, hipDeviceAttributeMultiprocessorCount, dev) != hipSuccess) { grid = -1; return; }
        if (hipFuncSetAttribute((const void*)mk_fwd, hipFuncAttributeMaxDynamicSharedMemorySize, LDS_BYTES) != hipSuccess) { fprintf(stderr, "kernel_launch: hipFuncSetAttribute failed\n"); grid = -1; return; }
        if (hipOccupancyMaxActiveBlocksPerMultiprocessor(&per_cu, (const void*)mk_fwd, NWAVES * 64, LDS_BYTES) != hipSuccess || per_cu < 1) { fprintf(stderr, "kernel_launch: occupancy query reports %d\n", per_cu); }
        (void)hipGetLastError();
        grid = cus;
    }
    if (grid < 0) return;
    if (hipMemsetAsync((char*)d_ws + WS_CTL, 0, CTL_ZERO_BYTES, stream) != hipSuccess) return;
    Args a{};
    for (int i = 0; i < 22; ++i) a.in[i] = (const float*)d_in[i];
    a.out = (float*)d_out; a.ws = (unsigned char*)d_ws;
    for (int li = 0; li < N_LAUNCHES; ++li) {
        if (N_LAUNCHES == 1) { a.ph_lo = 0; a.ph_hi = N_PHASES; } else { a.ph_lo = li; a.ph_hi = li + 1; }
        a.li = li; a.pad = 0;
        hipLaunchKernelGGL(mk_fwd, dim3(grid), dim3(NWAVES * 64), LDS_BYTES, stream, a);
    }
}
```

```cpp
#include <hip/hip_runtime.h>
#include <cstdio>
#include <cstdint>
namespace pg8 {
#define PG8_LAS __attribute__((address_space(3)))
typedef unsigned short bf16_t;
typedef short bf16x8 __attribute__((ext_vector_type(8)));
typedef float f32x4 __attribute__((ext_vector_type(4)));
typedef int i32x4 __attribute__((ext_vector_type(4)));
typedef unsigned u32x4 __attribute__((ext_vector_type(4)));
constexpr int BM = 256, BK = 64, HALF = 128, HTB = HALF * BK * 2  , STAGE_BYTES = 8 * HTB, NXCD = 8, WGM = 8;

__host__ __device__ __forceinline__ int lds_byte(int r, int c) { const int st = (r >> 4) * 2 + (c >> 5), rr = r & 15, cc = c & 31, ob = rr * 64 + cc * 2; return st * 1024 + (ob ^ (((ob >> 9) & 1) << 5)); }
__host__ __device__ __forceinline__ void stage_rc(int b, int& R, int& C) { const int st = b / 1024, sb = b % 1024, swz = sb ^ (((sb >> 9) & 1) << 5); R = (st >> 1) * 16 + swz / 64; C = (st & 1) * 32 + (swz % 64) / 2; }
__host__ __device__ __forceinline__ int perm32(int rho) { const int n = rho >> 4, i = rho & 15; return 8 * (i >> 2) + 4 * n + (i & 3); }

struct Unit { int pm, pn; };
struct Gemm { const bf16_t* A; const bf16_t* Bt; int M, N, K, lda, ldb; };

struct StaticOrder {
    int nM, nN, nwg, G, c;
    __host__ __device__ void init(int M, int N, int G_, int c_) { nM = M / BM; nN = N / BM; nwg = nM * nN; G = G_; c = c_; }
    __host__ __device__ bool next(int i, Unit& u) const {
        const long L = (long)i * G + c; if (L >= nwg) return false;
        int wgid = (int)L; { const int q = nwg / NXCD, r = nwg % NXCD, xcd = wgid % NXCD, off = wgid / NXCD; wgid = (xcd < r ? xcd * (q + 1) : r * (q + 1) + (xcd - r) * q) + off; }
        const int nig = WGM * nN, gid = wgid / nig, fm = gid * WGM, gsz = (nM - fm) < WGM ? (nM - fm) : WGM;
        u.pm = fm + ((wgid % nig) % gsz); u.pn = (wgid % nig) / gsz; return true;
    }
    __device__ __forceinline__ void a_ready(const Unit&) const {}
    __device__ __forceinline__ void done(const Unit&) const {}
};

__device__ __forceinline__ unsigned cvt_pk_bf16(float lo, float hi) { unsigned r; asm volatile("v_cvt_pk_bf16_f32 %0, %1, %2" : "=v"(r) : "v"(lo), "v"(hi)); return r; }
typedef unsigned u32x2 __attribute__((ext_vector_type(2)));
__device__ __forceinline__ float fast_sigmoid(float x) { return __builtin_amdgcn_rcpf(1.0f + __builtin_amdgcn_exp2f(-1.4426950408889634f * x)); }

struct EpiBf16 {
    static constexpr bool PERM = true, AFTER_DRAIN = false;
    bf16_t* O; int ldc;
    __device__ __forceinline__ void operator()(const f32x4 (&acc)[2][2][4][2], const Unit& u, int wr, int wc, int fr, int fq) const {
        const int row0 = u.pm * BM + wr * 64 + fr; const int col0 = u.pn * BM + wc * 32 + 8 * fq;
#pragma unroll
        for (int ai = 0; ai < 2; ++ai)
#pragma unroll
            for (int m = 0; m < 4; ++m) { bf16_t* rowp = O + (size_t)(row0 + ai * HALF + m * 16) * ldc + col0;
#pragma unroll
                for (int bj = 0; bj < 2; ++bj) { const f32x4 v0 = acc[ai][bj][m][0], v1 = acc[ai][bj][m][1];
                    u32x4 w; w.x = cvt_pk_bf16(v0[0], v0[1]); w.y = cvt_pk_bf16(v0[2], v0[3]); w.z = cvt_pk_bf16(v1[0], v1[1]); w.w = cvt_pk_bf16(v1[2], v1[3]);
                    *(u32x4*)(rowp + bj * HALF) = w; } }
    }
};
typedef _Float16 xh2 __attribute__((ext_vector_type(2))); typedef float xf2 __attribute__((ext_vector_type(2)));
__device__ __forceinline__ unsigned xpk(float lo, float hi) { const xf2 v = {lo, hi}; const xh2 h = __builtin_convertvector(v, xh2); return __builtin_bit_cast(unsigned, h); }
__device__ __forceinline__ float xlo(unsigned w) { const xh2 h = __builtin_bit_cast(xh2, w); return (float)h.x; }
__device__ __forceinline__ float xhi(unsigned w) { const xh2 h = __builtin_bit_cast(xh2, w); return (float)h.y; }
__device__ __forceinline__ float bflo(unsigned w) { return __uint_as_float(w << 16); }
__device__ __forceinline__ float bfhi(unsigned w) { return __uint_as_float(w & 0xffff0000u); }
typedef unsigned ssq_t;
constexpr float SSQ_SCALE = 1024.0f;
__device__ __forceinline__ float ss_get(const ssq_t* ss, int row) { return (float)ss[row] * (1.0f / SSQ_SCALE); }
__device__ __forceinline__ ssq_t ss_fix(float v) { return __float2uint_rn(v * SSQ_SCALE); }
struct RowScale { const ssq_t* ss; const float* dir; float invd, eps;
    __device__ __forceinline__ float operator()(int row) const { return dir ? dir[row] : __builtin_amdgcn_rsqf(ss_get(ss, row) * invd + eps); } };
__device__ __forceinline__ void ss_add(ssq_t* ss, int row, float v, int fq) { v += __shfl_xor(v, 16); v += __shfl_xor(v, 32); if (fq == 0) atomicAdd(ss + row, ss_fix(v)); }

struct EpiBf16Scale {
    static constexpr bool PERM = true, AFTER_DRAIN = false;
    bf16_t* O; int ldc; RowScale rs;
    __device__ __forceinline__ void operator()(const f32x4 (&acc)[2][2][4][2], const Unit& u, int wr, int wc, int fr, int fq) const {
        const int row0 = u.pm * BM + wr * 64 + fr; const int col0 = u.pn * BM + wc * 32 + 8 * fq;
        float rsc[2][4];
#pragma unroll
        for (int ai = 0; ai < 2; ++ai)
#pragma unroll
            for (int m = 0; m < 4; ++m) rsc[ai][m] = rs(row0 + ai * HALF + m * 16);
#pragma unroll
        for (int ai = 0; ai < 2; ++ai)
#pragma unroll
            for (int m = 0; m < 4; ++m) { const int row = row0 + ai * HALF + m * 16; const float r = rsc[ai][m]; bf16_t* rowp = O + (size_t)row * ldc + col0;
#pragma unroll
                for (int bj = 0; bj < 2; ++bj) { const f32x4 v0 = acc[ai][bj][m][0] * r, v1 = acc[ai][bj][m][1] * r;
                    u32x4 w; w.x = cvt_pk_bf16(v0[0], v0[1]); w.y = cvt_pk_bf16(v0[2], v0[3]); w.z = cvt_pk_bf16(v1[0], v1[1]); w.w = cvt_pk_bf16(v1[2], v1[3]);
                    *(u32x4*)(rowp + bj * HALF) = w; } }
    }
};
template <bool BASE_F32, bool OUT_F32> struct EpiRes {
    static constexpr bool PERM = true, AFTER_DRAIN = false;
    const void* base; int ldb; void* out; int ldo; ssq_t* ss;
    bf16_t* slab;
    bf16_t* bcopy;
    __device__ __forceinline__ void operator()(const f32x4 (&acc)[2][2][4][2], const Unit& u, int wr, int wc, int fr, int fq) const {
        int row0 = u.pm * BM + wr * 64 + fr; int col0 = u.pn * BM + wc * 32 + 8 * fq;
        asm volatile("" : "+v"(row0), "+v"(col0));
#pragma unroll
        for (int ai = 0; ai < 2; ++ai) {
            f32x4 b[4][2][2];
#pragma unroll
            for (int m = 0; m < 4; ++m) { const int row = row0 + ai * HALF + m * 16;
#pragma unroll
                for (int bj = 0; bj < 2; ++bj) {
                    if (BASE_F32) { const float* p = (const float*)base + (size_t)row * ldb + col0 + bj * HALF; b[m][bj][0] = *(const f32x4*)p; b[m][bj][1] = *(const f32x4*)(p + 4); }
                    else { const u32x4 w = *(const u32x4*)((const bf16_t*)base + (size_t)row * ldb + col0 + bj * HALF);
                        b[m][bj][0] = (f32x4){xlo(w.x), xhi(w.x), xlo(w.y), xhi(w.y)}; b[m][bj][1] = (f32x4){xlo(w.z), xhi(w.z), xlo(w.w), xhi(w.w)}; } } }
            asm volatile("" ::: "memory");
#pragma unroll
            for (int m = 0; m < 4; ++m) { const int row = row0 + ai * HALF + m * 16; float sq = 0.f;
#pragma unroll
                for (int bj = 0; bj < 2; ++bj) { const f32x4 v0 = b[m][bj][0] + acc[ai][bj][m][0], v1 = b[m][bj][1] + acc[ai][bj][m][1];
                    if (OUT_F32) { float* p = (float*)out + (size_t)row * ldo + col0 + bj * HALF; *(f32x4*)p = v0; *(f32x4*)(p + 4) = v1;
                        sq += (v0[0] * v0[0] + v0[1] * v0[1]) + (v0[2] * v0[2] + v0[3] * v0[3]) + (v1[0] * v1[0] + v1[1] * v1[1]) + (v1[2] * v1[2] + v1[3] * v1[3]); }
                    else { u32x4 w; w.x = xpk(v0[0], v0[1]); w.y = xpk(v0[2], v0[3]); w.z = xpk(v1[0], v1[1]); w.w = xpk(v1[2], v1[3]);
                        *(u32x4*)((bf16_t*)out + (size_t)row * ldo + col0 + bj * HALF) = w;
                        if (bcopy) { u32x4 wb; wb.x = cvt_pk_bf16(v0[0], v0[1]); wb.y = cvt_pk_bf16(v0[2], v0[3]); wb.z = cvt_pk_bf16(v1[0], v1[1]); wb.w = cvt_pk_bf16(v1[2], v1[3]); *(u32x4*)(bcopy + (size_t)row * ldo + col0 + bj * HALF) = wb; }
                        if (slab) { const int col = col0 + bj * HALF; *(u32x4*)(slab + ((size_t)(((row >> 12) * 256 + (col >> 4)) * 4096 + (row & 4095))) * 16 + (col & 8)) = w; }
                        const float a0 = xlo(w.x), a1 = xhi(w.x), a2 = xlo(w.y), a3 = xhi(w.y), a4 = xlo(w.z), a5 = xhi(w.z), a6 = xlo(w.w), a7 = xhi(w.w);
                        sq += (a0 * a0 + a1 * a1) + (a2 * a2 + a3 * a3) + (a4 * a4 + a5 * a5) + (a6 * a6 + a7 * a7); } }
                ss_add(ss, row, sq, fq); }
            asm volatile("" ::: "memory");
        }
    }
};
struct EpiGluRes {
    static constexpr bool PERM = true, AFTER_DRAIN = false;
    bf16_t* X; int ldx; ssq_t* ss;
    __device__ __forceinline__ void operator()(const f32x4 (&acc)[2][2][4][2], const Unit& u, int wr, int wc, int fr, int fq) const {
        const int row0 = u.pm * BM + wr * 64 + fr, col0 = u.pn * HALF + wc * 32 + 8 * fq;
        u32x4 b[2][4];
#pragma unroll
        for (int ai = 0; ai < 2; ++ai)
#pragma unroll
            for (int m = 0; m < 4; ++m) b[ai][m] = *(const u32x4*)(X + (size_t)(row0 + ai * HALF + m * 16) * ldx + col0);
        asm volatile("" ::: "memory");
#pragma unroll
        for (int ai = 0; ai < 2; ++ai)
#pragma unroll
            for (int m = 0; m < 4; ++m) { const int row = row0 + ai * HALF + m * 16; const u32x4 w0 = b[ai][m];
                const f32x4 a0 = acc[ai][0][m][0], g0 = acc[ai][1][m][0], a1 = acc[ai][0][m][1], g1 = acc[ai][1][m][1];
                const float o0 = xlo(w0.x) + a0[0] * fast_sigmoid(g0[0]), o1 = xhi(w0.x) + a0[1] * fast_sigmoid(g0[1]), o2 = xlo(w0.y) + a0[2] * fast_sigmoid(g0[2]), o3 = xhi(w0.y) + a0[3] * fast_sigmoid(g0[3]);
                const float o4 = xlo(w0.z) + a1[0] * fast_sigmoid(g1[0]), o5 = xhi(w0.z) + a1[1] * fast_sigmoid(g1[1]), o6 = xlo(w0.w) + a1[2] * fast_sigmoid(g1[2]), o7 = xhi(w0.w) + a1[3] * fast_sigmoid(g1[3]);
                u32x4 w; w.x = xpk(o0, o1); w.y = xpk(o2, o3); w.z = xpk(o4, o5); w.w = xpk(o6, o7);
                *(u32x4*)(X + (size_t)row * ldx + col0) = w;
                const float q0 = xlo(w.x), q1 = xhi(w.x), q2 = xlo(w.y), q3 = xhi(w.y), q4 = xlo(w.z), q5 = xhi(w.z), q6 = xlo(w.w), q7 = xhi(w.w);
                ss_add(ss, row, (q0 * q0 + q1 * q1) + (q2 * q2 + q3 * q3) + (q4 * q4 + q5 * q5) + (q6 * q6 + q7 * q7), fq); }
    }
};
struct EpiConvGate {
    static constexpr bool PERM = true, AFTER_DRAIN = false;
    bf16_t* ACT; int ldc;
    float* HEAD; float* TAIL;
    const float* cw; const float* cb; int FF, NUP;
    RowScale rs;
    PG8_LAS float* tl;
    const float* wsc;
    __device__ __forceinline__ void operator()(const f32x4 (&acc)[2][2][4][2], const Unit& u, int wr, int wc, int fr, int fq) const {
        asm volatile("" : "+v"(fr), "+v"(fq));
        float rsc[2][4];
#pragma unroll
        for (int ai = 0; ai < 2; ++ai)
#pragma unroll
            for (int m = 0; m < 4; ++m) rsc[ai][m] = rs(u.pm * BM + ai * HALF + wr * 64 + m * 16 + fr);
        const int lcol = wc * 32 + 8 * fq;
        if (fr >= 14) {
#pragma unroll
            for (int ai = 0; ai < 2; ++ai)
#pragma unroll
                for (int bj = 0; bj < 2; ++bj)
#pragma unroll
                    for (int n = 0; n < 2; ++n) *(PG8_LAS f32x4*)(tl + ((2 * ai + wr) * 2 + (fr - 14)) * 256 + bj * HALF + lcol + 4 * n) = acc[ai][bj][3][n] * rsc[ai][3];
        }
        asm volatile("s_waitcnt lgkmcnt(0)" ::: "memory"); __builtin_amdgcn_s_barrier(); asm volatile("" ::: "memory");
#pragma unroll
        for (int n = 0; n < 2; ++n) {
            const int f0 = u.pn * HALF + lcol + 4 * n;
            const int nn = u.pn * BM + lcol + 4 * n;
            f32x4 w0[2], w1[2], w2[2], bb[2];
#pragma unroll
            for (int bj = 0; bj < 2; ++bj) { const float* p = cw + bj * FF + f0; w0[bj] = *(const f32x4*)p; w1[bj] = *(const f32x4*)(p + NUP); w2[bj] = *(const f32x4*)(p + 2 * NUP); bb[bj] = *(const f32x4*)(cb + bj * FF + f0); }
            if (wsc) {
#pragma unroll
                for (int bj = 0; bj < 2; ++bj) { const f32x4 sc = *(const f32x4*)(wsc + nn + bj * HALF); w0[bj] = w0[bj] * sc; w1[bj] = w1[bj] * sc; w2[bj] = w2[bj] * sc; } }
#pragma unroll
            for (int ai = 0; ai < 2; ++ai) {
                const int blkl = 2 * ai + wr;
                if (blkl == 0 && fr < 2) { float* hp = HEAD + (unsigned)((u.pm * 2 + fr) * NUP + nn); *(f32x4*)hp = acc[0][0][0][n] * rsc[0][0]; *(f32x4*)(hp + HALF) = acc[0][1][0][n] * rsc[0][0]; }
                if (blkl == 3 && fr >= 14) { float* tp = TAIL + (unsigned)((u.pm * 2 + (fr - 14)) * NUP + nn); *(f32x4*)tp = acc[1][0][3][n] * rsc[1][3]; *(f32x4*)(tp + HALF) = acc[1][1][3][n] * rsc[1][3]; }
                f32x4 tlv[2];
#pragma unroll
                for (int bj = 0; bj < 2; ++bj) tlv[bj] = *(const PG8_LAS f32x4*)(tl + ((blkl > 0 ? blkl - 1 : 0) * 2 + (fr & 1)) * 256 + bj * HALF + lcol + 4 * n);
#pragma unroll
                for (int m = 0; m < 4; ++m) {
                    f32x4 c[2];
#pragma unroll
                    for (int bj = 0; bj < 2; ++bj) {
                        const f32x4 cur = acc[ai][bj][m][n] * rsc[ai][m], prv = m > 0 ? acc[ai][bj][m > 0 ? m - 1 : 0][n] * rsc[ai][m > 0 ? m - 1 : 0] : tlv[bj];
                        f32x4 u1, u2;
#pragma unroll
                        for (int j = 0; j < 4; ++j) {
                            const float cf = cur[j], pf = prv[j]; const int ci = __float_as_int(cf), pi = __float_as_int(pf);
                            const int p1 = __builtin_amdgcn_update_dpp(0, pi, 0x10F, 0xf, 0xf, true);
                            const int p2 = __builtin_amdgcn_update_dpp(0, pi, 0x10E, 0xf, 0xf, true);
                            u1[j] = __int_as_float(__builtin_amdgcn_update_dpp(p1, ci, 0x111, 0xf, 0xf, false));
                            u2[j] = __int_as_float(__builtin_amdgcn_update_dpp(p2, ci, 0x112, 0xf, 0xf, false));
                        }
                        c[bj] = bb[bj] + w0[bj] * u2 + w1[bj] * u1 + w2[bj] * cur;
                    }
                    f32x4 o;
#pragma unroll
                    for (int j = 0; j < 4; ++j) o[j] = c[0][j] * fast_sigmoid(c[0][j]) * c[1][j];
                    u32x2 w; w.x = cvt_pk_bf16(o[0], o[1]); w.y = cvt_pk_bf16(o[2], o[3]);
                    *(u32x2*)(ACT + (size_t)(u.pm * BM + ai * HALF + wr * 64 + m * 16 + fr) * ldc + f0) = w;
                }
            }
        }
    }
};

typedef _Float16 f16x8 __attribute__((ext_vector_type(8)));
template <bool F16> __device__ __forceinline__ f32x4 mma16(const bf16x8 b, const bf16x8 a, const f32x4 c) {
    if constexpr (F16) return __builtin_amdgcn_mfma_f32_16x16x32_f16(__builtin_bit_cast(f16x8, b), __builtin_bit_cast(f16x8, a), c, 0, 0, 0);
    else return __builtin_amdgcn_mfma_f32_16x16x32_bf16(b, a, c, 0, 0, 0);
}
template <class Epi, class Sched, bool ALIGN_EPI = false, bool SP2 = false, bool F16 = false>
__device__ __forceinline__ void gemm_phase(PG8_LAS unsigned char* lds, const Gemm g, const Sched& S, const Epi& E, const int tz = 0) {
    const int tid = threadIdx.x + tz, wid = __builtin_amdgcn_readfirstlane(tid >> 6), lane = tid & 63, wr = wid >> 2, wc = wid & 3, fr = lane & 15, fq = lane >> 4;
    const int K = g.K, nt = K / BK;
    unsigned voffA[2], voffB[2];
#pragma unroll
    for (int i = 0; i < 2; ++i) { int R, C; stage_rc(tid * 16 + i * 8192, R, C); const int Rb = Epi::PERM ? ((R & ~31) + perm32(R & 31)) : R;
        voffA[i] = (unsigned)(R * g.lda + C) * 2u; voffB[i] = (unsigned)(Rb * g.ldb + C) * 2u; }
    const size_t kstep = (size_t)(BK * 2);
    const size_t hstepA = (size_t)HALF * g.lda * 2, hstepB = (size_t)HALF * g.ldb * 2;
    const size_t tstepA = 2 * hstepA, tstepB = 2 * hstepB;
    const unsigned ldsw = (unsigned)wid * 1024u;
    const int aoff = lds_byte(wr * 64 + fr, fq * 8), boff = lds_byte(wc * 32 + fr, fq * 8);
#define PG8_SA(b, h) (((b) * 2 + (h)) * HTB)
#define PG8_SB(b, h) ((4 + (b) * 2 + (h)) * HTB)
#define PG8_STAGE(bufoff, gbase, voff) do { _Pragma("unroll") for (int _i = 0; _i < 2; ++_i) \
        __builtin_amdgcn_global_load_lds((const unsigned*)((const char*)(gbase) + (voff)[_i]), (PG8_LAS unsigned*)(lds + (bufoff) + ldsw + _i * 8192), 16, 0, 0); } while (0)
#define PG8_LDA(dst, b, h) do { _Pragma("unroll") for (int m = 0; m < 4; ++m) _Pragma("unroll") for (int k = 0; k < 2; ++k) dst[m][k] = *(const PG8_LAS bf16x8*)(lds + PG8_SA(b, h) + aoff + m * 2048 + k * 1024); } while (0)
#define PG8_LDB(dst, b, h) do { _Pragma("unroll") for (int n = 0; n < 2; ++n) _Pragma("unroll") for (int k = 0; k < 2; ++k) dst[n][k] = *(const PG8_LAS bf16x8*)(lds + PG8_SB(b, h) + boff + n * 2048 + k * 1024); } while (0)
#define PG8_MMA(ai, bj, At, Bt) do { __builtin_amdgcn_s_setprio(1); _Pragma("unroll") for (int m = 0; m < 4; ++m) _Pragma("unroll") for (int n = 0; n < 2; ++n) _Pragma("unroll") for (int k = 0; k < 2; ++k) \
        acc[ai][bj][m][n] = mma16<F16>(Bt[n][k], At[m][k], acc[ai][bj][m][n]); __builtin_amdgcn_s_setprio(0); } while (0)
#define PG8_WAIT_V(n) asm volatile("s_waitcnt vmcnt(" #n ")" ::: "memory")
#define PG8_WAIT_L(n) asm volatile("s_waitcnt lgkmcnt(" #n ")" ::: "memory")
#define PG8_BAR __builtin_amdgcn_s_barrier()
#define PG8_SCHED __builtin_amdgcn_sched_barrier(0)
    Unit cur, nxt; int ui = 0;
    if (!S.next(0, cur)) return;
    f32x4 acc[2][2][4][2];
#pragma unroll
    for (int a = 0; a < 2; ++a)
#pragma unroll
        for (int b = 0; b < 2; ++b)
#pragma unroll
            for (int m = 0; m < 4; ++m)
#pragma unroll
                for (int n = 0; n < 2; ++n) acc[a][b][m][n] = (f32x4){0.f, 0.f, 0.f, 0.f};
    bf16x8 At[4][2], B0[2][2], B1[2][2];
    const char* cA = (const char*)g.A + (size_t)cur.pm * tstepA; const char* cB = (const char*)g.Bt + (size_t)cur.pn * tstepB;
    S.a_ready(cur);
    if constexpr (SP2) {
        PG8_STAGE(PG8_SB(0, 0), cB, voffB); PG8_STAGE(PG8_SB(0, 1), cB + hstepB, voffB); PG8_STAGE(PG8_SA(0, 0), cA, voffA); PG8_STAGE(PG8_SA(0, 1), cA + hstepA, voffA);
        if (wr == 1) PG8_BAR;
        PG8_WAIT_V(2); PG8_BAR;
        PG8_STAGE(PG8_SB(1, 0), cB + kstep, voffB); PG8_STAGE(PG8_SA(1, 0), cA + kstep, voffA); PG8_STAGE(PG8_SB(1, 1), cB + hstepB + kstep, voffB);
        PG8_WAIT_V(6); PG8_BAR;
    } else {
        PG8_STAGE(PG8_SB(0, 0), cB, voffB); PG8_STAGE(PG8_SA(0, 0), cA, voffA); PG8_STAGE(PG8_SB(0, 1), cB + hstepB, voffB); PG8_STAGE(PG8_SA(0, 1), cA + hstepA, voffA);
        if (wr == 1) PG8_BAR;
        PG8_WAIT_V(4); PG8_BAR;
        PG8_STAGE(PG8_SB(1, 0), cB + kstep, voffB); PG8_STAGE(PG8_SA(1, 0), cA + kstep, voffA); PG8_STAGE(PG8_SB(1, 1), cB + hstepB + kstep, voffB);
        PG8_WAIT_V(6); PG8_BAR;
    }
    for (;;) {
        const bool has_next = S.next(ui + 1, nxt);
        const char* nA = has_next ? (const char*)g.A + (size_t)nxt.pm * tstepA : cA; const char* nB = has_next ? (const char*)g.Bt + (size_t)nxt.pn * tstepB : cB;
        for (int t = 0; t < nt; t += 2) {
            const bool last = (t == nt - 2);
            const char* a1 = cA + (size_t)(t + 1) * kstep;
            const char* a2 = last ? nA : cA + (size_t)(t + 2) * kstep; const char* b2 = last ? nB : cB + (size_t)(t + 2) * kstep;
            const char* a3 = a2 + kstep; const char* b3 = b2 + kstep;
            if (last && has_next) S.a_ready(nxt);
            if constexpr (SP2) {
            PG8_LDB(B0, 0, 0); PG8_LDB(B1, 0, 1); PG8_SCHED; PG8_LDA(At, 0, 0); PG8_STAGE(PG8_SA(1, 1), a1 + hstepA, voffA);
            PG8_WAIT_V(8); PG8_WAIT_L(0); PG8_BAR; PG8_MMA(0, 0, At, B0); PG8_MMA(0, 1, At, B1); PG8_BAR; PG8_SCHED;
            PG8_LDA(At, 0, 1); PG8_STAGE(PG8_SB(0, 0), b2, voffB); PG8_STAGE(PG8_SB(0, 1), b2 + hstepB, voffB); PG8_STAGE(PG8_SA(0, 0), a2, voffA);
            PG8_WAIT_V(8); PG8_WAIT_L(0); PG8_BAR; PG8_MMA(1, 0, At, B0); PG8_MMA(1, 1, At, B1); PG8_BAR; PG8_SCHED;
            PG8_LDB(B0, 1, 0); PG8_LDB(B1, 1, 1); PG8_SCHED; PG8_LDA(At, 1, 0); PG8_STAGE(PG8_SA(0, 1), a2 + hstepA, voffA);
            PG8_WAIT_V(8); PG8_WAIT_L(0); PG8_BAR; PG8_MMA(0, 0, At, B0); PG8_MMA(0, 1, At, B1); PG8_BAR; PG8_SCHED;
            PG8_LDA(At, 1, 1); PG8_STAGE(PG8_SB(1, 0), b3, voffB); PG8_STAGE(PG8_SB(1, 1), b3 + hstepB, voffB); PG8_STAGE(PG8_SA(1, 0), a3, voffA);
            PG8_WAIT_V(8); PG8_WAIT_L(0); PG8_BAR; PG8_MMA(1, 0, At, B0); PG8_MMA(1, 1, At, B1); PG8_BAR; PG8_SCHED;
            } else {
            PG8_LDB(B0, 0, 0); PG8_SCHED; PG8_LDA(At, 0, 0); PG8_STAGE(PG8_SA(1, 1), a1 + hstepA, voffA);
            PG8_WAIT_L(8); PG8_BAR; PG8_WAIT_L(0); PG8_MMA(0, 0, At, B0); PG8_BAR; PG8_SCHED;
            PG8_LDB(B1, 0, 1); PG8_STAGE(PG8_SB(0, 0), b2, voffB);
            PG8_BAR; PG8_WAIT_L(0); PG8_MMA(0, 1, At, B1); PG8_BAR;
            PG8_LDA(At, 0, 1); PG8_STAGE(PG8_SA(0, 0), a2, voffA);
            PG8_BAR; PG8_WAIT_L(0); PG8_MMA(1, 0, At, B0); PG8_BAR; PG8_SCHED;
            PG8_STAGE(PG8_SB(0, 1), b2 + hstepB, voffB);
            PG8_WAIT_V(6); PG8_BAR; PG8_MMA(1, 1, At, B1); PG8_BAR;
            PG8_LDB(B0, 1, 0); PG8_SCHED; PG8_LDA(At, 1, 0); PG8_STAGE(PG8_SA(0, 1), a2 + hstepA, voffA);
            PG8_WAIT_L(8); PG8_BAR; PG8_WAIT_L(0); PG8_MMA(0, 0, At, B0); PG8_BAR; PG8_SCHED;
            PG8_LDB(B1, 1, 1); PG8_STAGE(PG8_SB(1, 0), b3, voffB);
            PG8_BAR; PG8_WAIT_L(0); PG8_MMA(0, 1, At, B1); PG8_BAR;
            PG8_LDA(At, 1, 1); PG8_STAGE(PG8_SA(1, 0), a3, voffA);
            PG8_BAR; PG8_WAIT_L(0); PG8_MMA(1, 0, At, B0); PG8_BAR; PG8_SCHED;
            PG8_STAGE(PG8_SB(1, 1), b3 + hstepB, voffB);
            PG8_WAIT_V(6); PG8_BAR; PG8_MMA(1, 1, At, B1); PG8_BAR;
            }
        }
        if constexpr (ALIGN_EPI) { if (wr == 0) PG8_BAR; }
        if constexpr (!Epi::AFTER_DRAIN) { E(acc, cur, wr, wc, fr, fq); S.done(cur); }
        if (!has_next) break;
#pragma unroll
        for (int a = 0; a < 2; ++a)
#pragma unroll
            for (int b = 0; b < 2; ++b)
#pragma unroll
                for (int m = 0; m < 4; ++m)
#pragma unroll
                    for (int n = 0; n < 2; ++n) acc[a][b][m][n] = (f32x4){0.f, 0.f, 0.f, 0.f};
        cur = nxt; cA = nA; cB = nB; ++ui;
        if constexpr (ALIGN_EPI) { if (wr == 1) PG8_BAR; }
    }
    PG8_WAIT_V(0);
    if constexpr (!ALIGN_EPI) { if (wr == 0) PG8_BAR; }
    PG8_BAR;
    if constexpr (Epi::AFTER_DRAIN) { E.fused(acc, cur, wr, wc, fr, fq, lds, wid, lane); S.done(cur); }
#undef PG8_SA
#undef PG8_SB
#undef PG8_STAGE
#undef PG8_LDA
#undef PG8_LDB
#undef PG8_MMA
#undef PG8_WAIT_V
#undef PG8_WAIT_L
#undef PG8_BAR
#undef PG8_SCHED
}
template <class Epi, class Sched, bool ALIGN_EPI = false, bool SP2 = false>
__device__ __forceinline__ void gemm_phase_i8(PG8_LAS unsigned char* lds, const Gemm g, const Sched& S, const Epi& E) {
    const int tid = threadIdx.x, wid = __builtin_amdgcn_readfirstlane(tid >> 6), lane = tid & 63, wr = wid >> 2, wc = wid & 3, fr = lane & 15, fq = lane >> 4;
    const int K = g.K, nt = K / BK;
    unsigned voffA[2], voffB[2];
#pragma unroll
    for (int i = 0; i < 2; ++i) { int R, C; stage_rc(tid * 16 + i * 8192, R, C); const int Rb = Epi::PERM ? ((R & ~31) + perm32(R & 31)) : R;
        voffA[i] = (unsigned)(R * g.lda + C) * 2u; voffB[i] = (unsigned)(Rb * g.ldb + C) * 2u; }
    const size_t kstep = (size_t)(BK * 2);
    const size_t hstepA = (size_t)HALF * g.lda * 2, hstepB = (size_t)HALF * g.ldb * 2;
    const size_t tstepA = 2 * hstepA, tstepB = 2 * hstepB;
    const unsigned ldsw = (unsigned)wid * 1024u;
    const int aoff = lds_byte(wr * 64 + fr, fq * 8), boff = lds_byte(wc * 32 + fr, fq * 8);
#define PG8_SA(b, h) (((b) * 2 + (h)) * HTB)
#define PG8_SB(b, h) ((4 + (b) * 2 + (h)) * HTB)
#define PG8_STAGE(bufoff, gbase, voff) do { _Pragma("unroll") for (int _i = 0; _i < 2; ++_i) \
        __builtin_amdgcn_global_load_lds((const unsigned*)((const char*)(gbase) + (voff)[_i]), (PG8_LAS unsigned*)(lds + (bufoff) + ldsw + _i * 8192), 16, 0, 0); } while (0)
#define PG8_LDA(dst, b, h) do { _Pragma("unroll") for (int m = 0; m < 4; ++m) _Pragma("unroll") for (int k = 0; k < 2; ++k) dst[m][k] = *(const PG8_LAS bf16x8*)(lds + PG8_SA(b, h) + aoff + m * 2048 + k * 1024); } while (0)
#define PG8_LDB(dst, b, h) do { _Pragma("unroll") for (int n = 0; n < 2; ++n) _Pragma("unroll") for (int k = 0; k < 2; ++k) dst[n][k] = *(const PG8_LAS bf16x8*)(lds + PG8_SB(b, h) + boff + n * 2048 + k * 1024); } while (0)
#define PG8_MMA(ai, bj, At, Bt) do { __builtin_amdgcn_s_setprio(1); _Pragma("unroll") for (int m = 0; m < 4; ++m) _Pragma("unroll") for (int n = 0; n < 2; ++n) _Pragma("unroll") for (int k = 0; k < 2; ++k) \
        acc[ai][bj][m][n] = __builtin_amdgcn_mfma_i32_16x16x64_i8(__builtin_bit_cast(i32x4, Bt[n][k]), __builtin_bit_cast(i32x4, At[m][k]), acc[ai][bj][m][n], 0, 0, 0); __builtin_amdgcn_s_setprio(0); } while (0)
#define PG8_WAIT_V(n) asm volatile("s_waitcnt vmcnt(" #n ")" ::: "memory")
#define PG8_WAIT_L(n) asm volatile("s_waitcnt lgkmcnt(" #n ")" ::: "memory")
#define PG8_BAR __builtin_amdgcn_s_barrier()
#define PG8_SCHED __builtin_amdgcn_sched_barrier(0)
    Unit cur, nxt; int ui = 0;
    if (!S.next(0, cur)) return;
    i32x4 acc[2][2][4][2];
#pragma unroll
    for (int a = 0; a < 2; ++a)
#pragma unroll
        for (int b = 0; b < 2; ++b)
#pragma unroll
            for (int m = 0; m < 4; ++m)
#pragma unroll
                for (int n = 0; n < 2; ++n) acc[a][b][m][n] = (i32x4){0, 0, 0, 0};
    bf16x8 At[4][2], B0[2][2], B1[2][2];
    const char* cA = (const char*)g.A + (size_t)cur.pm * tstepA; const char* cB = (const char*)g.Bt + (size_t)cur.pn * tstepB;
    S.a_ready(cur);
    if constexpr (SP2) {
        PG8_STAGE(PG8_SB(0, 0), cB, voffB); PG8_STAGE(PG8_SB(0, 1), cB + hstepB, voffB); PG8_STAGE(PG8_SA(0, 0), cA, voffA); PG8_STAGE(PG8_SA(0, 1), cA + hstepA, voffA);
        if (wr == 1) PG8_BAR;
        PG8_WAIT_V(2); PG8_BAR;
        PG8_STAGE(PG8_SB(1, 0), cB + kstep, voffB); PG8_STAGE(PG8_SA(1, 0), cA + kstep, voffA); PG8_STAGE(PG8_SB(1, 1), cB + hstepB + kstep, voffB);
        PG8_WAIT_V(6); PG8_BAR;
    } else {
        PG8_STAGE(PG8_SB(0, 0), cB, voffB); PG8_STAGE(PG8_SA(0, 0), cA, voffA); PG8_STAGE(PG8_SB(0, 1), cB + hstepB, voffB); PG8_STAGE(PG8_SA(0, 1), cA + hstepA, voffA);
        if (wr == 1) PG8_BAR;
        PG8_WAIT_V(4); PG8_BAR;
        PG8_STAGE(PG8_SB(1, 0), cB + kstep, voffB); PG8_STAGE(PG8_SA(1, 0), cA + kstep, voffA); PG8_STAGE(PG8_SB(1, 1), cB + hstepB + kstep, voffB);
        PG8_WAIT_V(6); PG8_BAR;
    }
    for (;;) {
        const bool has_next = S.next(ui + 1, nxt);
        const char* nA = has_next ? (const char*)g.A + (size_t)nxt.pm * tstepA : cA; const char* nB = has_next ? (const char*)g.Bt + (size_t)nxt.pn * tstepB : cB;
        for (int t = 0; t < nt; t += 2) {
            const bool last = (t == nt - 2);
            const char* a1 = cA + (size_t)(t + 1) * kstep;
            const char* a2 = last ? nA : cA + (size_t)(t + 2) * kstep; const char* b2 = last ? nB : cB + (size_t)(t + 2) * kstep;
            const char* a3 = a2 + kstep; const char* b3 = b2 + kstep;
            if (last && has_next) S.a_ready(nxt);
            if constexpr (SP2) {
            PG8_LDB(B0, 0, 0); PG8_LDB(B1, 0, 1); PG8_SCHED; PG8_LDA(At, 0, 0); PG8_STAGE(PG8_SA(1, 1), a1 + hstepA, voffA);
            PG8_WAIT_V(8); PG8_WAIT_L(0); PG8_BAR; PG8_MMA(0, 0, At, B0); PG8_MMA(0, 1, At, B1); PG8_BAR; PG8_SCHED;
            PG8_LDA(At, 0, 1); PG8_STAGE(PG8_SB(0, 0), b2, voffB); PG8_STAGE(PG8_SB(0, 1), b2 + hstepB, voffB); PG8_STAGE(PG8_SA(0, 0), a2, voffA);
            PG8_WAIT_V(8); PG8_WAIT_L(0); PG8_BAR; PG8_MMA(1, 0, At, B0); PG8_MMA(1, 1, At, B1); PG8_BAR; PG8_SCHED;
            PG8_LDB(B0, 1, 0); PG8_LDB(B1, 1, 1); PG8_SCHED; PG8_LDA(At, 1, 0); PG8_STAGE(PG8_SA(0, 1), a2 + hstepA, voffA);
            PG8_WAIT_V(8); PG8_WAIT_L(0); PG8_BAR; PG8_MMA(0, 0, At, B0); PG8_MMA(0, 1, At, B1); PG8_BAR; PG8_SCHED;
            PG8_LDA(At, 1, 1); PG8_STAGE(PG8_SB(1, 0), b3, voffB); PG8_STAGE(PG8_SB(1, 1), b3 + hstepB, voffB); PG8_STAGE(PG8_SA(1, 0), a3, voffA);
            PG8_WAIT_V(8); PG8_WAIT_L(0); PG8_BAR; PG8_MMA(1, 0, At, B0); PG8_MMA(1, 1, At, B1); PG8_BAR; PG8_SCHED;
            } else {
            PG8_LDB(B0, 0, 0); PG8_SCHED; PG8_LDA(At, 0, 0); PG8_STAGE(PG8_SA(1, 1), a1 + hstepA, voffA);
            PG8_WAIT_L(8); PG8_BAR; PG8_WAIT_L(0); PG8_MMA(0, 0, At, B0); PG8_BAR; PG8_SCHED;
            PG8_LDB(B1, 0, 1); PG8_STAGE(PG8_SB(0, 0), b2, voffB);
            PG8_BAR; PG8_WAIT_L(0); PG8_MMA(0, 1, At, B1); PG8_BAR;
            PG8_LDA(At, 0, 1); PG8_STAGE(PG8_SA(0, 0), a2, voffA);
            PG8_BAR; PG8_WAIT_L(0); PG8_MMA(1, 0, At, B0); PG8_BAR; PG8_SCHED;
            PG8_STAGE(PG8_SB(0, 1), b2 + hstepB, voffB);
            PG8_WAIT_V(6); PG8_BAR; PG8_MMA(1, 1, At, B1); PG8_BAR;
            PG8_LDB(B0, 1, 0); PG8_SCHED; PG8_LDA(At, 1, 0); PG8_STAGE(PG8_SA(0, 1), a2 + hstepA, voffA);
            PG8_WAIT_L(8); PG8_BAR; PG8_WAIT_L(0); PG8_MMA(0, 0, At, B0); PG8_BAR; PG8_SCHED;
            PG8_LDB(B1, 1, 1); PG8_STAGE(PG8_SB(1, 0), b3, voffB);
            PG8_BAR; PG8_WAIT_L(0); PG8_MMA(0, 1, At, B1); PG8_BAR;
            PG8_LDA(At, 1, 1); PG8_STAGE(PG8_SA(1, 0), a3, voffA);
            PG8_BAR; PG8_WAIT_L(0); PG8_MMA(1, 0, At, B0); PG8_BAR; PG8_SCHED;
            PG8_STAGE(PG8_SB(1, 1), b3 + hstepB, voffB);
            PG8_WAIT_V(6); PG8_BAR; PG8_MMA(1, 1, At, B1); PG8_BAR;
            }
        }
        if constexpr (ALIGN_EPI) { if (wr == 0) PG8_BAR; }
        if constexpr (!Epi::AFTER_DRAIN) {
            f32x4 accf[2][2][4][2];
#pragma unroll
            for (int a = 0; a < 2; ++a)
#pragma unroll
                for (int b = 0; b < 2; ++b)
#pragma unroll
                    for (int m = 0; m < 4; ++m)
#pragma unroll
                        for (int n = 0; n < 2; ++n) accf[a][b][m][n] = __builtin_convertvector(acc[a][b][m][n], f32x4);
            E(accf, cur, wr, wc, fr, fq); S.done(cur); }
        if (!has_next) break;
#pragma unroll
        for (int a = 0; a < 2; ++a)
#pragma unroll
            for (int b = 0; b < 2; ++b)
#pragma unroll
                for (int m = 0; m < 4; ++m)
#pragma unroll
                    for (int n = 0; n < 2; ++n) acc[a][b][m][n] = (i32x4){0, 0, 0, 0};
        cur = nxt; cA = nA; cB = nB; ++ui;
        if constexpr (ALIGN_EPI) { if (wr == 1) PG8_BAR; }
    }
    PG8_WAIT_V(0);
    if constexpr (!ALIGN_EPI) { if (wr == 0) PG8_BAR; }
    PG8_BAR;
#undef PG8_SA
#undef PG8_SB
#undef PG8_STAGE
#undef PG8_LDA
#undef PG8_LDB
#undef PG8_MMA
#undef PG8_WAIT_V
#undef PG8_WAIT_L
#undef PG8_BAR
#undef PG8_SCHED
}
}
#define GAS __attribute__((address_space(1)))
#define LAS __attribute__((address_space(3)))
typedef unsigned short bf16;
typedef unsigned v4u __attribute__((ext_vector_type(4)));
typedef float f32x4 __attribute__((ext_vector_type(4)));
typedef short bf16x8 __attribute__((ext_vector_type(8)));
typedef GAS unsigned gu32;
typedef GAS unsigned long long gu64;
#define RLX_AGENT __ATOMIC_RELAXED, __HIP_MEMORY_SCOPE_AGENT
#define LDS_WAIT() asm volatile("s_waitcnt lgkmcnt(0)" ::: "memory")
#define VM_WAIT() asm volatile("s_waitcnt vmcnt(0)" ::: "memory")
__device__ __forceinline__ unsigned long long rt() { return __builtin_amdgcn_s_memrealtime(); }
__device__ __forceinline__ unsigned f2bf(float f) { unsigned u = __builtin_bit_cast(unsigned, f); return (u + 0x7fffu + ((u >> 16) & 1u)) >> 16; }
typedef __bf16 hw_bf16x2 __attribute__((ext_vector_type(2))); typedef float hw_f32x2 __attribute__((ext_vector_type(2)));
__device__ __forceinline__ unsigned pk2(float lo, float hi) { const hw_f32x2 v = {lo, hi}; return __builtin_bit_cast(unsigned, __builtin_convertvector(v, hw_bf16x2)); }

#define XB_TMO      128
#define XB_XCNT(j)  (256  + 64 * (j))
#define XB_XSUB(j)  (1280 + 64 * (j))
#define XB_XGEN(j)  (2304 + 64 * (j))
#define XB_TOP      3328
#define XB_TOPGEN   3392
#define XCD_BAR_WORDS 3456
#define XB_SPIN_CAP (1u << 18)

__device__ __forceinline__ unsigned xb_ld(unsigned* p)              { return __hip_atomic_load(p, __ATOMIC_RELAXED, __HIP_MEMORY_SCOPE_AGENT); }
__device__ __forceinline__ unsigned xb_add(unsigned* p, unsigned v) { return __hip_atomic_fetch_add(p, v, __ATOMIC_RELAXED, __HIP_MEMORY_SCOPE_AGENT); }
__device__ __forceinline__ unsigned xb_xcc_id() { return (unsigned)__builtin_amdgcn_s_getreg((3 << 11) | 20) & 0xFu; }
#define XB_SPIN(cond, bar) do { unsigned _sp = 0; while (cond) { __builtin_amdgcn_s_sleep(1); \
    if ((++_sp & 255u) == 0u) { if (xb_ld(&(bar)[XB_TMO])) break; if (_sp > XB_SPIN_CAP) { atomicAdd(&(bar)[XB_TMO], 1u); break; } } } } while (0)

struct XcdBarrier {
    unsigned* bar; unsigned x;
    volatile LAS unsigned* st;
};

__device__ __forceinline__ XcdBarrier xcd_barrier_post(unsigned* bar, volatile LAS unsigned* st) {
    XcdBarrier b; b.bar = bar; b.x = xb_xcc_id(); b.st = st;
    if (threadIdx.x == 0) (void)xb_add(&bar[XB_XCNT(b.x)], 1u);
    return b;
}
__device__ __forceinline__ void xcd_barrier_complete(unsigned* bar, unsigned x, unsigned& nloc, unsigned& nx) {
    const unsigned G = gridDim.x * gridDim.y * gridDim.z;
    unsigned sum, cnt, mine, sp = 0u;
    for (;;) {
        sum = 0u; cnt = 0u; mine = 0u;
#pragma unroll
        for (unsigned j = 0; j < 16; ++j) { const unsigned c = xb_ld(&bar[XB_XCNT(j)]); sum += c; cnt += (c > 0u) ? 1u : 0u; mine = (j == x) ? c : mine; }
        if (sum == G) break;
        __builtin_amdgcn_s_sleep(1);
        if ((++sp & 255u) == 0u) { if (xb_ld(&bar[XB_TMO])) break; if (sp > XB_SPIN_CAP) { atomicAdd(&bar[XB_TMO], 1u); break; } }
    }
    nloc = mine > 0u ? mine : 1u; nx = cnt > 0u ? cnt : 1u;
}

__device__ __forceinline__ void xcd_barrier(const XcdBarrier& b) {
    asm volatile("s_waitcnt vmcnt(0)" ::: "memory");
    __syncthreads();
    if (threadIdx.x == 0) {
        unsigned* bar = b.bar;
        __builtin_amdgcn_s_waitcnt(0);
        unsigned nloc = b.st[0], nx = b.st[1];
        if (nloc == 0u) { xcd_barrier_complete(bar, b.x, nloc, nx); b.st[0] = nloc; b.st[1] = nx; }
        const unsigned old = xb_add(&bar[XB_XSUB(b.x)], 1u);
        const unsigned gen = old / nloc;
        if (old + 1u == (gen + 1u) * nloc) {
            __builtin_amdgcn_fence(__ATOMIC_RELEASE, "agent");
            asm volatile("s_waitcnt vmcnt(0)" ::: "memory");
            const unsigned og = xb_add(&bar[XB_TOP], 1u);
            const unsigned tg = og / nx;
            if (og + 1u == (tg + 1u) * nx) xb_add(&bar[XB_TOPGEN], 1u);
            else XB_SPIN(xb_ld(&bar[XB_TOPGEN]) == tg, bar);
            __builtin_amdgcn_fence(__ATOMIC_ACQUIRE, "agent");
            xb_add(&bar[XB_XGEN(b.x)], 1u);
            asm volatile("s_waitcnt vmcnt(0)" ::: "memory");
        } else {
            XB_SPIN(xb_ld(&bar[XB_XGEN(b.x)]) == gen, bar);
            __builtin_amdgcn_fence(__ATOMIC_ACQUIRE, "agent");
            asm volatile("s_waitcnt vmcnt(0)" ::: "memory");
        }
    }
    __syncthreads();
}

constexpr int NWAVES = 8;
constexpr int BATCH = 2, SEQ = 4096, DM = 4096, M = BATCH * SEQ;
constexpr int NH = 64, NKV = 8, HD = 64, QKVW = 5120;
constexpr int FF = 11008, NUP = 2 * FF;
constexpr int SG = 256, SGC = 16, SP = 64;
constexpr float EPS = 1e-6f;
constexpr int LDX = DM + 128, LDACT = FF + 128;
constexpr int LDW = DM + 128, LDWF = FF + 128;
#ifndef MK_N_LAUNCHES
#define MK_N_LAUNCHES 1
#endif
constexpr int N_PHASES = 13;
constexpr int N_LAUNCHES = MK_N_LAUNCHES;

constexpr size_t MiB = 1u << 20;
constexpr size_t WS_CTL = 0, CTL_ZERO_BYTES = 1 * MiB;
constexpr size_t WS_WQKV = 2 * MiB;
constexpr size_t WS_WO   = WS_WQKV + 42 * MiB;
constexpr size_t WS_WUP0 = WS_WO + 34 * MiB;
constexpr size_t WS_WUP1 = WS_WUP0 + 178 * MiB;
constexpr size_t WS_WDN0 = WS_WUP1 + 178 * MiB;
constexpr size_t WS_WDN1 = WS_WDN0 + 88 * MiB;
constexpr size_t WS_WGLU = WS_WDN1 + 88 * MiB;
constexpr size_t WS_X    = WS_WGLU + 67 * MiB;
constexpr size_t WS_XN   = WS_X + 128 * MiB;
constexpr size_t WS_QKV  = WS_XN + 67 * MiB;
constexpr size_t WS_AO   = WS_QKV + 80 * MiB;
constexpr size_t WS_ACT  = WS_AO + 67 * MiB;
constexpr size_t WS_HEAD = WS_ACT + 175 * MiB;
constexpr size_t WS_TAIL = WS_HEAD + 22 * MiB;
constexpr size_t WS_S5KT = WS_TAIL + 22 * MiB;
constexpr size_t WS_S5BE = WS_S5KT + 5 * MiB;
constexpr size_t WS_S5CP = WS_S5BE + 32 * MiB;
constexpr size_t WS_S5AT = WS_S5CP + 32 * MiB;
constexpr size_t WS_S5H  = WS_S5AT + 1 * MiB;
#ifndef UP0_I8_TILES
#define UP0_I8_TILES 48
#endif
constexpr int NI8 = UP0_I8_TILES * 256;
constexpr int LDQ = DM + 256;
constexpr size_t WS_XQ   = WS_S5H + 64 * MiB;
constexpr size_t WS_WQ1  = WS_XQ + 36 * MiB;
constexpr size_t WS_ASC  = WS_WQ1 + 92 * MiB;
constexpr size_t WS_WSC1 = WS_ASC + 1 * MiB;
constexpr size_t WS_WQ0  = WS_WSC1 + 1 * MiB;
constexpr size_t WS_WSC0 = WS_WQ0 + 92 * MiB;
constexpr size_t WS_XNB  = WS_WSC0 + 1 * MiB;
constexpr size_t WS_END  = WS_XNB + 67 * MiB;
static_assert((size_t)M * LDQ <= 36 * MiB && (size_t)NUP * LDQ <= 92 * MiB, "int8 ws map");
constexpr size_t WS_SS = 262144;
static_assert((size_t)QKVW * LDW * 2 <= 42 * MiB && (size_t)DM * LDW * 2 <= 34 * MiB && (size_t)NUP * LDW * 2 <= 178 * MiB && (size_t)DM * LDWF * 2 <= 88 * MiB && (size_t)2 * DM * LDW * 2 <= 67 * MiB && (size_t)M * LDX * 2 <= 67 * MiB && (size_t)M * LDACT * 2 <= 175 * MiB && (size_t)(M / 64) * 2 * NUP * 4 <= 22 * MiB, "ws map");
constexpr int CW_BAR = 4096;

constexpr int RING_OFF = 0, RING_BYTES = 131072;
constexpr int LDSCTL_OFF = RING_BYTES, MISC_OFF = LDSCTL_OFF + 320;
constexpr int LDS_BYTES = 147456;
static_assert(MISC_OFF + 128 <= LDS_BYTES, "LDS map");

typedef unsigned v2u __attribute__((ext_vector_type(2)));
using pg8::ssq_t; using pg8::ss_get; using pg8::ss_fix; using pg8::xpk; using pg8::xlo; using pg8::xhi;
struct Frame {
    LAS unsigned char* lds;
    volatile LAS unsigned* MISC;
    gu32* ctl;
    int tid, lane, wave;
    int vcu, G;
};
__device__ __forceinline__ float wave_sum(float v) {
#pragma unroll
    for (int o = 1; o < 64; o <<= 1) v += __shfl_xor(v, o);
    return v;
}
__device__ __forceinline__ float bf_lo(unsigned w) { return __uint_as_float(w << 16); }
__device__ __forceinline__ float bf_hi(unsigned w) { return __uint_as_float(w & 0xffff0000u); }

__device__ __forceinline__ int rowmap(int n, int Hh) { if (Hh == 0) return n; const int half = n >= Hh ? 1 : 0; const int f = n - half * Hh; return ((f >> 7) << 8) + (half << 7) + (f & 127); }
struct CvtJob { const float* W; bf16* WT; const float* gain; int N, ldw, Hh, k0, n0, kgl, h16; };
constexpr int CI_QKV = (DM / 64) * (QKVW / 32), CI_O = (DM / 64) * (DM / 32), CI_UP = (DM / 64) * (NUP / 32), CI_DN = (FF / 64) * (DM / 32), CI_GLU = (DM / 64) * (2 * DM / 32);
constexpr int CI_UP0 = (DM / 64) * ((NUP - NI8) / 32);
static_assert(((NUP - NI8) / 32) % 16 == 0 && (NI8 / 2) % 32 == 0, "bf16 part of the layer-0 up weights: whole super-blocks");
constexpr int CVT_ITEMS = CI_QKV + CI_O + CI_UP0 + 2 * CI_DN + CI_GLU;
#ifndef CVT_Q1
#define CVT_Q1 12
#endif
#ifndef CVT_Q2
#define CVT_Q2 14
#endif
constexpr int CVT_W1 = 128 * NWAVES, CVT_W2 = 64 * NWAVES;
constexpr int CVT_N1 = CVT_W1 * CVT_Q1, CVT_N2 = CVT_W2 * CVT_Q2, CVT_NP = CVT_ITEMS - CVT_N1 - CVT_N2;
static_assert(CVT_NP >= CI_QKV + CI_O + CI_UP0 + CI_DN, "the prologue must convert everything layer 0 needs");
__device__ __forceinline__ CvtJob cvt_job(int it, const float* const* in, unsigned char* ws) {
    CvtJob j; int r = it; j.gain = nullptr; bool up0 = false;
    j.h16 = 0;
    if (r < CI_QKV) { j.W = in[2]; j.WT = (bf16*)(ws + WS_WQKV); j.N = QKVW; j.ldw = LDW; j.Hh = 0; j.gain = in[1]; j.kgl = 3; }
    else if ((r -= CI_QKV) < CI_O) { j.W = in[3]; j.WT = (bf16*)(ws + WS_WO); j.N = DM; j.ldw = LDW; j.Hh = 0; j.kgl = 3; }
    else if ((r -= CI_O) < CI_UP0) { up0 = true; j.W = in[17]; j.WT = (bf16*)(ws + WS_WUP0); j.N = NUP; j.ldw = LDW; j.Hh = FF; j.gain = in[16]; j.kgl = 4; }
    else if ((r -= CI_UP0) < CI_DN) { j.W = in[20]; j.WT = (bf16*)(ws + WS_WDN0); j.N = DM; j.ldw = LDWF; j.Hh = 0; j.kgl = 2; }
    else if ((r -= CI_DN) < CI_GLU) { j.W = in[15]; j.WT = (bf16*)(ws + WS_WGLU); j.N = 2 * DM; j.ldw = LDW; j.Hh = DM; j.kgl = 3; }
    else { r -= CI_GLU; j.W = in[20] + (size_t)FF * DM; j.WT = (bf16*)(ws + WS_WDN1); j.N = DM; j.ldw = LDWF; j.Hh = 0; j.kgl = 2; }
    const int ngl = 8 - j.kgl, nblk = up0 ? (NUP - NI8) >> 5 : j.N >> 5, ngrp = nblk >> ngl;
    const int sb = r >> 8, wi = r & 255, kgi = sb / ngrp, ngi = sb - kgi * ngrp;
    const int kb = (kgi << j.kgl) + (wi >> ngl), nb = (ngi << ngl) + (wi & ((1 << ngl) - 1));
    j.k0 = 64 * kb; j.n0 = 32 * nb;
    if (up0) j.n0 += (j.n0 < (NUP - NI8) / 2) ? NI8 / 2 : NI8 / 2 + NI8 / 2;
    return j;
}
__device__ __forceinline__ void cvt_load(const CvtJob& j, int lane, f32x4 (&v)[8], float (&gk)[8]) {
    const float* p = j.W + (size_t)(j.k0 + (lane >> 3)) * j.N + j.n0 + 4 * (lane & 7);
#pragma unroll
    for (int i = 0; i < 8; ++i) v[i] = __builtin_nontemporal_load((const GAS f32x4*)(p + (size_t)(8 * i) * j.N));
    const float* gp = (j.gain ? j.gain : j.W) + j.k0 + (lane >> 3);
#pragma unroll
    for (int i = 0; i < 8; ++i) { const float t = gp[8 * i]; gk[i] = j.gain ? t : 1.0f; }
}
__device__ __forceinline__ void cvt_store(const CvtJob& j, int lane, const f32x4 (&v)[8], const float (&gk)[8], LAS float* scr) {
    const int kr = lane >> 3, nq = 4 * (lane & 7);
#pragma unroll
    for (int i = 0; i < 8; ++i) { LAS float* d = scr + (8 * i + kr) * 33 + nq; d[0] = v[i].x * gk[i]; d[1] = v[i].y * gk[i]; d[2] = v[i].z * gk[i]; d[3] = v[i].w * gk[i]; }
    LDS_WAIT(); asm volatile("" ::: "memory");
    const int c = lane & 7; const int r0 = rowmap(j.n0, j.Hh);
#pragma unroll
    for (int jj = 0; jj < 4; ++jj) { const int n = (lane >> 3) + 8 * jj; const LAS float* s = scr + (8 * c) * 33 + n;
        v4u o;
        if (j.h16) { o.x = xpk(s[0 * 33], s[1 * 33]); o.y = xpk(s[2 * 33], s[3 * 33]); o.z = xpk(s[4 * 33], s[5 * 33]); o.w = xpk(s[6 * 33], s[7 * 33]); }
        else { o.x = pk2(s[0 * 33], s[1 * 33]); o.y = pk2(s[2 * 33], s[3 * 33]); o.z = pk2(s[4 * 33], s[5 * 33]); o.w = pk2(s[6 * 33], s[7 * 33]); }
        __builtin_nontemporal_store(o, (GAS v4u*)(j.WT + (size_t)(r0 + n) * j.ldw + j.k0 + 8 * c)); }
    LDS_WAIT(); asm volatile("" ::: "memory");
}
__device__ __forceinline__ void convert_weights(Frame& F, const float* const* in, unsigned char* ws, int first, int count, int rank, int nwaves) {
    LAS float* scr = (LAS float*)(F.lds + RING_OFF + F.wave * 16384);
    const int end = first + count, last = end - 1;
    int it = first + rank; if (it >= end) return;
    CvtJob jA = cvt_job(it, in, ws); f32x4 vA[8]; float gA[8]; cvt_load(jA, F.lane, vA, gA);
    CvtJob jB = cvt_job(min(it + nwaves, last), in, ws); f32x4 vB[8]; float gB[8]; cvt_load(jB, F.lane, vB, gB);
    for (; it < end; it += 2 * nwaves) {
        cvt_store(jA, F.lane, vA, gA, scr);                     asm volatile("" ::: "memory");
        jA = cvt_job(min(it + 2 * nwaves, last), in, ws); cvt_load(jA, F.lane, vA, gA);   asm volatile("" ::: "memory");
        if (it + nwaves < end) cvt_store(jB, F.lane, vB, gB, scr);   asm volatile("" ::: "memory");
        jB = cvt_job(min(it + 3 * nwaves, last), in, ws); cvt_load(jB, F.lane, vB, gB);   asm volatile("" ::: "memory");
    }
}
__device__ __forceinline__ unsigned q4(float a, float b, float c, float e, float inv) {
    const int i0 = __float2int_rn(a * inv), i1 = __float2int_rn(b * inv), i2 = __float2int_rn(c * inv), i3 = __float2int_rn(e * inv);
    return (unsigned)(i0 & 0xff) | ((unsigned)(i1 & 0xff) << 8) | ((unsigned)(i2 & 0xff) << 16) | ((unsigned)(i3 & 0xff) << 24);
}
constexpr int NPAN0 = NI8 / 32, NPAN1 = NUP / 32, NPAN = NPAN0 + NPAN1;
__device__ __forceinline__ void convert_panels(Frame& F, const float* const* in, unsigned char* ws, int first, int count, int rank, int nwg) {
    LAS unsigned char* pan = F.lds + RING_OFF;
    LAS unsigned* cmax = (LAS unsigned*)(F.lds + LDSCTL_OFF + 1024);
    const int t = F.tid, c8 = t & 7, r = t >> 3;
    const int end = first + count;
#define PAN_R0(p_) (32 * ((p_) >= NPAN0 ? (p_) - NPAN0 : (p_)))
#define PAN_SRC(p_) (in[17] + ((p_) >= NPAN0 ? (size_t)DM * NUP : (size_t)0) + (((PAN_R0(p_) >> 7) & 1) * FF + (PAN_R0(p_) >> 8) * 128 + (PAN_R0(p_) & 127)) + 4 * c8 + (size_t)(2 * r) * NUP)
#define PAN_LOAD(dst_, src_, b_) do { const float* q_ = (src_) + (size_t)(512 * (b_)) * NUP; asm volatile("" : "+v"(q_));     \
        _Pragma("unroll") for (int i = 0; i < 8; ++i) dst_[i] = __builtin_nontemporal_load((const GAS f32x4*)(q_ + (size_t)(128 * (i >> 1) + (i & 1)) * NUP)); } while (0)
#define PAN_PUT(src_, b_) do { \
        _Pragma("unroll") for (int i = 0; i < 4; ++i) { const unsigned gw = *(const LAS unsigned*)(gl + 4 * (r + 64 * (4 * (b_) + i))); const float ge = xlo(gw), go = xhi(gw); \
            const f32x4 a = src_[2 * i] * ge, c = src_[2 * i + 1] * go; \
            am0 = fmaxf(am0, fmaxf(fabsf(a.x), fabsf(c.x))); am1 = fmaxf(am1, fmaxf(fabsf(a.y), fabsf(c.y))); am2 = fmaxf(am2, fmaxf(fabsf(a.z), fabsf(c.z))); am3 = fmaxf(am3, fmaxf(fabsf(a.w), fabsf(c.w))); \
            LAS unsigned char* d = pan + (2 * c8) * 8192 + (((unsigned)(4 * (r + 64 * (4 * (b_) + i)))) ^ ((unsigned)c8 << 5)); \
            *(LAS unsigned*)(d) = xpk(a.x, c.x); *(LAS unsigned*)(d + 8192) = xpk(a.y, c.y); pz[4 * (b_) + i] = xpk(a.z, c.z); pw[4 * (b_) + i] = xpk(a.w, c.w); } } while (0)
#define PAN_QUANT(hi_) do { int tq = threadIdx.x; asm volatile("" : "+v"(tq)); const int slot = tq >> 5, l = tq & 31, col = 4 * (slot >> 1) + 2 * (hi_) + (slot & 1); const float mx = __uint_as_float(cmax[col]); const float inv = mx > 0.f ? 127.0f / mx : 0.f; \
        const unsigned key = (unsigned)(slot >> 1) << 5; GAS v2u* qo = (GAS v2u*)(Q + (size_t)(r0 + col) * LDQ); \
        _Pragma("unroll 4") for (int i = 0; i < 16; ++i) { const int ch = l + 32 * i; const v4u w = *(const LAS v4u*)(pan + slot * 8192 + (((unsigned)(16 * ch)) ^ key)); \
            v2u o; o.x = q4(xlo(w.x), xhi(w.x), xlo(w.y), xhi(w.y), inv); o.y = q4(xlo(w.z), xhi(w.z), xlo(w.w), xhi(w.w), inv); qo[ch] = o; } \
        if (l == 0) sc[r0 + col] = mx * (1.0f / 127.0f); } while (0)
    int p = first + rank; if (p >= end) return;
    f32x4 v0[8], v1[8]; unsigned pz[32], pw[32];
    LAS unsigned char* gl = F.lds + LDSCTL_OFF + 1280;
    int cur = -1;
    PAN_LOAD(v0, PAN_SRC(p), 0);
    __syncthreads();
    for (; p < end; p += nwg) {
        const bool l1 = p >= NPAN0; const int r0 = PAN_R0(p);
        if ((int)l1 != cur) { cur = (int)l1; const float* gain = in[16] + (l1 ? DM : 0);
            for (int i = t; i < DM / 2; i += 512) *(LAS unsigned*)(gl + 4 * i) = xpk(gain[2 * i], gain[2 * i + 1]);
            __syncthreads(); }
        unsigned char* Q = ws + (l1 ? WS_WQ1 : WS_WQ0); float* sc = (float*)(ws + (l1 ? WS_WSC1 : WS_WSC0));
        { int tz_ = threadIdx.x; asm volatile("" : "+v"(tz_)); if (tz_ < 32) cmax[tz_] = 0u; }
        float am0 = 0.f, am1 = 0.f, am2 = 0.f, am3 = 0.f;
        const float* src = PAN_SRC(p);
        PAN_LOAD(v1, src, 1); PAN_PUT(v0, 0); asm volatile("" ::: "memory");
        PAN_LOAD(v0, src, 2); PAN_PUT(v1, 1); asm volatile("" ::: "memory");
        PAN_LOAD(v1, src, 3); PAN_PUT(v0, 2); asm volatile("" ::: "memory");
        PAN_LOAD(v0, src, 4); PAN_PUT(v1, 3); asm volatile("" ::: "memory");
        PAN_LOAD(v1, src, 5); PAN_PUT(v0, 4); asm volatile("" ::: "memory");
        PAN_LOAD(v0, src, 6); PAN_PUT(v1, 5); asm volatile("" ::: "memory");
        PAN_LOAD(v1, src, 7); PAN_PUT(v0, 6); asm volatile("" ::: "memory");
        { const int pnx = (p + nwg < end) ? p + nwg : p; PAN_LOAD(v0, PAN_SRC(pnx), 0); }
        PAN_PUT(v1, 7); asm volatile("" ::: "memory");
#pragma unroll
        for (int o = 8; o < 64; o <<= 1) { am0 = fmaxf(am0, __shfl_xor(am0, o)); am1 = fmaxf(am1, __shfl_xor(am1, o)); am2 = fmaxf(am2, __shfl_xor(am2, o)); am3 = fmaxf(am3, __shfl_xor(am3, o)); }
        __syncthreads();
        if (F.lane < 8) { atomicMax((unsigned*)(cmax + 4 * c8), __float_as_uint(am0)); atomicMax((unsigned*)(cmax + 4 * c8 + 1), __float_as_uint(am1)); atomicMax((unsigned*)(cmax + 4 * c8 + 2), __float_as_uint(am2)); atomicMax((unsigned*)(cmax + 4 * c8 + 3), __float_as_uint(am3)); }
        __syncthreads();
        PAN_QUANT(0);
        __syncthreads();
#pragma unroll
        for (int i = 0; i < 32; ++i) { LAS unsigned char* d = pan + (2 * c8) * 8192 + (((unsigned)(4 * (r + 64 * i))) ^ ((unsigned)c8 << 5)); *(LAS unsigned*)(d) = pz[i]; *(LAS unsigned*)(d + 8192) = pw[i]; }
        __syncthreads();
        PAN_QUANT(1);
        __syncthreads();
    }
#undef PAN_R0
#undef PAN_SRC
#undef PAN_LOAD
#undef PAN_PUT
#undef PAN_QUANT
}
__device__ __forceinline__ void x0_rows(Frame& F, const float* src, bf16* xb, bf16* xb2, ssq_t* ss) {
    const int gw = F.vcu * NWAVES + F.wave, NGW = F.G * NWAVES;
    for (int m = gw; m < M; m += NGW) {
        const GAS f32x4* xr = (const GAS f32x4*)(src + (size_t)m * DM) + F.lane;
        GAS unsigned long long* o8 = (GAS unsigned long long*)(xb + (size_t)m * LDX) + F.lane; float s = 0.f;
        GAS unsigned long long* p8 = (GAS unsigned long long*)(xb2 + (size_t)m * LDX) + F.lane;
#pragma unroll
        for (int j = 0; j < 16; ++j) { const f32x4 v = xr[64 * j]; const unsigned w0 = xpk(v.x, v.y), w1 = xpk(v.z, v.w); o8[64 * j] = (unsigned long long)w0 | ((unsigned long long)w1 << 32); { const unsigned b0 = pk2(v.x, v.y), b1 = pk2(v.z, v.w); p8[64 * j] = (unsigned long long)b0 | ((unsigned long long)b1 << 32); }
            const float a = xlo(w0), b = xhi(w0), c = xlo(w1), d = xhi(w1); s += (a * a + b * b) + (c * c + d * d); }
        s = wave_sum(s); if (F.lane == 0) ss[m] = ss_fix(s);
    }
}
__device__ __forceinline__ void final_rows(Frame& F, const bf16* xb, const ssq_t* ss, const float* gain, float* dst) {
    const int gw = F.vcu * NWAVES + F.wave, NGW = F.G * NWAVES;
    int lane_ = threadIdx.x; asm volatile("" : "+v"(lane_)); lane_ &= 63;
    for (int m = gw; m < M; m += NGW) {
        const float rstd = 1.0f / sqrtf(ss_get(ss, m) * (1.0f / DM) + EPS);
        const GAS v4u* xr = (const GAS v4u*)(xb + (size_t)m * LDX) + lane_; const GAS f32x4* gr = (const GAS f32x4*)gain + 2 * lane_; GAS f32x4* o = (GAS f32x4*)(dst + (size_t)m * DM) + 2 * lane_;
        v4u w[8];
#pragma unroll
        for (int j = 0; j < 8; ++j) w[j] = xr[64 * j];
#pragma unroll
        for (int j = 0; j < 8; ++j) { const f32x4 g0 = gr[128 * j], g1 = gr[128 * j + 1]; f32x4 r0, r1;
            r0.x = xlo(w[j].x) * rstd * g0.x; r0.y = xhi(w[j].x) * rstd * g0.y; r0.z = xlo(w[j].y) * rstd * g0.z; r0.w = xhi(w[j].y) * rstd * g0.w;
            r1.x = xlo(w[j].z) * rstd * g1.x; r1.y = xhi(w[j].z) * rstd * g1.y; r1.z = xlo(w[j].w) * rstd * g1.z; r1.w = xhi(w[j].w) * rstd * g1.w;
            __builtin_nontemporal_store(r0, o + 128 * j); __builtin_nontemporal_store(r1, o + 128 * j + 1); }
    }
}
__device__ __forceinline__ float wave_max(float v) {
#pragma unroll
    for (int o = 1; o < 64; o <<= 1) v = fmaxf(v, __shfl_xor(v, o));
    return v;
}
template <bool XH> __device__ __forceinline__ float qlo(unsigned w) { if constexpr (XH) return xlo(w); else return bf_lo(w); }
template <bool XH> __device__ __forceinline__ float qhi(unsigned w) { if constexpr (XH) return xhi(w); else return bf_hi(w); }
template <bool XH>
__device__ __forceinline__ void quant_rows(Frame& F, const bf16* X, int row0, int nrows, int ld, unsigned char* Q, float* scale, const ssq_t* ss, int gw, int NGW) {
    for (int m = row0 + gw; m < nrows; m += 2 * NGW) {
        const int m1 = m + NGW; const bool two = m1 < nrows; const int mb = two ? m1 : m;
        const GAS v4u* xr = (const GAS v4u*)(X + (size_t)m * ld) + F.lane; const GAS v4u* xs = (const GAS v4u*)(X + (size_t)mb * ld) + F.lane;
        v4u w[8], z[8]; float mx = 0.f, my = 0.f;
#pragma unroll
        for (int j = 0; j < 8; ++j) w[j] = xr[64 * j];
#pragma unroll
        for (int j = 0; j < 8; ++j) z[j] = xs[64 * j];
        float rs0 = 1.0f, rs1 = 1.0f;
        if (ss) { rs0 = 1.0f / sqrtf(ss_get(ss, m) * (1.0f / DM) + EPS); rs1 = 1.0f / sqrtf(ss_get(ss, mb) * (1.0f / DM) + EPS); }
#pragma unroll
        for (int j = 0; j < 8; ++j) {
            mx = fmaxf(mx, fmaxf(fmaxf(fabsf(qlo<XH>(w[j].x)), fabsf(qhi<XH>(w[j].x))), fmaxf(fabsf(qlo<XH>(w[j].y)), fabsf(qhi<XH>(w[j].y)))));
            mx = fmaxf(mx, fmaxf(fmaxf(fabsf(qlo<XH>(w[j].z)), fabsf(qhi<XH>(w[j].z))), fmaxf(fabsf(qlo<XH>(w[j].w)), fabsf(qhi<XH>(w[j].w))))); }
#pragma unroll
        for (int j = 0; j < 8; ++j) {
            my = fmaxf(my, fmaxf(fmaxf(fabsf(qlo<XH>(z[j].x)), fabsf(qhi<XH>(z[j].x))), fmaxf(fabsf(qlo<XH>(z[j].y)), fabsf(qhi<XH>(z[j].y)))));
            my = fmaxf(my, fmaxf(fmaxf(fabsf(qlo<XH>(z[j].z)), fabsf(qhi<XH>(z[j].z))), fmaxf(fabsf(qlo<XH>(z[j].w)), fabsf(qhi<XH>(z[j].w))))); }
        mx = wave_max(mx); my = wave_max(my);
        const float inv = mx > 0.f ? 127.0f / mx : 0.f, inw = my > 0.f ? 127.0f / my : 0.f;
        GAS v2u* qo = (GAS v2u*)(Q + (size_t)m * LDQ) + F.lane;
#pragma unroll
        for (int j = 0; j < 8; ++j) { v2u o; o.x = q4(qlo<XH>(w[j].x), qhi<XH>(w[j].x), qlo<XH>(w[j].y), qhi<XH>(w[j].y), inv); o.y = q4(qlo<XH>(w[j].z), qhi<XH>(w[j].z), qlo<XH>(w[j].w), qhi<XH>(w[j].w), inv); qo[64 * j] = o; }
        if (F.lane == 0) scale[m] = mx * (1.0f / 127.0f) * rs0;
        if (two) {
            GAS v2u* qp = (GAS v2u*)(Q + (size_t)m1 * LDQ) + F.lane;
#pragma unroll
            for (int j = 0; j < 8; ++j) { v2u o; o.x = q4(qlo<XH>(z[j].x), qhi<XH>(z[j].x), qlo<XH>(z[j].y), qhi<XH>(z[j].y), inw); o.y = q4(qlo<XH>(z[j].z), qhi<XH>(z[j].z), qlo<XH>(z[j].w), qhi<XH>(z[j].w), inw); qp[64 * j] = o; }
            if (F.lane == 0) scale[m1] = my * (1.0f / 127.0f) * rs1;
        }
    }
}
__device__ __forceinline__ int t5_bucket(int n) { if (n < 16) return n; const int b = 16 + (int)(__log2f((float)n * 0.0625f) * (16.0f / 3.0f)); return b < 31 ? b : 31; }

typedef float f32x16 __attribute__((ext_vector_type(16)));
typedef __bf16 bf16x2_t __attribute__((ext_vector_type(2)));
typedef float f32x2_t __attribute__((ext_vector_type(2)));
__device__ __forceinline__ unsigned cvtpk(float lo, float hi) { f32x2_t v = {lo, hi}; bf16x2_t b = __builtin_convertvector(v, bf16x2_t); return __builtin_bit_cast(unsigned, b); }
#define MFMA32(a, b, c) __builtin_amdgcn_mfma_f32_32x32x16_bf16((a), (b), (c), 0, 0, 0)
constexpr int AT_KSTR = 144, AT_VSTR = 528;
constexpr int AT_LDS_K = 0, AT_LDS_V = 256 * AT_KSTR, AT_LDS_B = AT_LDS_V + 64 * AT_VSTR, AT_LDS_END = AT_LDS_B + NWAVES * 768;
static_assert(AT_LDS_END <= RING_BYTES, "attention LDS map");
__device__ __forceinline__ int crow16(int i, int h) { return (i & 3) + 8 * (i >> 2) + 4 * h; }
__device__ __forceinline__ void attn_mfma(Frame& F, const bf16* QKV, const float* sinks, const float* rel_bias, bf16* AO) {
    LAS unsigned char* Ks = F.lds + AT_LDS_K; LAS unsigned char* Vt = F.lds + AT_LDS_V; LAS float* tb = (LAS float*)(F.lds + AT_LDS_B + F.wave * 768);
    const int lane = F.lane, r = lane & 31, h = lane >> 5, w = F.wave;
    const float LOG2E = 1.4426950408889634f, SC = 0.125f * LOG2E;
    for (int unit = (int)blockIdx.x; unit < BATCH * 32 * NKV; unit += F.G) {
        const int kvh = unit & 7, nb = (unit >> 3) & 31, b = unit >> 8, head = kvh * 8 + w;
        for (int e = lane; e < 192; e += 64) { const int dist = e - 32; tb[e] = (dist >= 0 && dist < 128) ? rel_bias[t5_bucket(dist) * NH + head] * LOG2E : -1e30f; }
        const float sink2 = sinks[head] * LOG2E;
        const long long row0 = (long long)b * SEQ + (nb - 1) * 128;
#pragma unroll
        for (int i = 0; i < 4; ++i) {
            const int c = F.tid + 512 * i, key = c >> 3, dc = c & 7;
            if (nb > 0 || key >= 128) {
                const bf16* src = QKV + (size_t)(row0 + key) * QKVW + DM + kvh * 64 + dc * 8;
                const v4u kk = *(const v4u*)src, vv = *(const v4u*)(src + 512);
                *(LAS v4u*)(Ks + key * AT_KSTR + dc * 16) = kk;
                LAS unsigned short* vp = (LAS unsigned short*)(Vt + (dc * 8) * AT_VSTR + key * 2);
                vp[0 * 264] = (unsigned short)(vv.x & 0xffffu); vp[1 * 264] = (unsigned short)(vv.x >> 16); vp[2 * 264] = (unsigned short)(vv.y & 0xffffu); vp[3 * 264] = (unsigned short)(vv.y >> 16);
                vp[4 * 264] = (unsigned short)(vv.z & 0xffffu); vp[5 * 264] = (unsigned short)(vv.z >> 16); vp[6 * 264] = (unsigned short)(vv.w & 0xffffu); vp[7 * 264] = (unsigned short)(vv.w >> 16);
            }
        }
        bf16x8 qf[4];
        { const bf16* qp = QKV + ((size_t)b * SEQ + nb * 128 + r) * QKVW + head * 64 + 8 * h;
#pragma unroll
          for (int ks = 0; ks < 4; ++ks) qf[ks] = *(const bf16x8*)(qp + 16 * ks); }
        __syncthreads();
#pragma unroll 1
        for (int qt = 0; qt < 4; ++qt) {
            const size_t qrow = (size_t)b * SEQ + nb * 128 + 32 * qt + r;
            bf16x8 qn[4];
            { const bf16* qp = QKV + (qrow + (qt < 3 ? 32 : 0)) * QKVW + head * 64 + 8 * h;
#pragma unroll
              for (int ks = 0; ks < 4; ++ks) qn[ks] = *(const bf16x8*)(qp + 16 * ks); }
            f32x16 S[5];
            float m = sink2;
#pragma unroll
            for (int e = 0; e < 5; ++e) {
                const int kb = qt + e;
                if (nb > 0 || kb >= 4) {
                    f32x16 acc;
#pragma unroll
                    for (int i = 0; i < 16; ++i) acc[i] = 0.f;
#pragma unroll
                    for (int ks = 0; ks < 4; ++ks) { const bf16x8 a = *(const LAS bf16x8*)(Ks + (32 * kb + r) * AT_KSTR + (16 * ks + 8 * h) * 2); acc = MFMA32(a, qf[ks], acc); }
#pragma unroll
                    for (int i = 0; i < 16; ++i) { const float s = acc[i] * SC + tb[160 - 32 * e + r - crow16(i, h)]; S[e][i] = s; m = fmaxf(m, s); }
                } else {
#pragma unroll
                    for (int i = 0; i < 16; ++i) S[e][i] = -1e30f;
                }
            }
            m = fmaxf(m, __shfl_xor(m, 32));
            float l = 0.f;
#pragma unroll
            for (int e = 0; e < 5; ++e)
#pragma unroll
                for (int i = 0; i < 16; ++i) { const float p = __builtin_amdgcn_exp2f(S[e][i] - m); S[e][i] = p; l += p; }
            l += __shfl_xor(l, 32);
            l += __builtin_amdgcn_exp2f(sink2 - m);
            f32x16 O0, O1;
#pragma unroll
            for (int i = 0; i < 16; ++i) { O0[i] = 0.f; O1[i] = 0.f; }
#pragma unroll
            for (int e = 0; e < 5; ++e) {
                const int kb = qt + e;
                if (nb > 0 || kb >= 4) {
#pragma unroll
                    for (int s = 0; s < 2; ++s) {
                        v4u pw; pw.x = cvtpk(S[e][8 * s], S[e][8 * s + 1]); pw.y = cvtpk(S[e][8 * s + 2], S[e][8 * s + 3]); pw.z = cvtpk(S[e][8 * s + 4], S[e][8 * s + 5]); pw.w = cvtpk(S[e][8 * s + 6], S[e][8 * s + 7]);
                        const bf16x8 pb = __builtin_bit_cast(bf16x8, pw);
                        const LAS unsigned char* vb = Vt + r * AT_VSTR + (32 * kb + 16 * s + 4 * h) * 2;
                        { const v2u lo = *(const LAS v2u*)vb, hi = *(const LAS v2u*)(vb + 16); v4u aw; aw.x = lo.x; aw.y = lo.y; aw.z = hi.x; aw.w = hi.y; O0 = MFMA32(__builtin_bit_cast(bf16x8, aw), pb, O0); }
                        { const v2u lo = *(const LAS v2u*)(vb + 32 * AT_VSTR), hi = *(const LAS v2u*)(vb + 32 * AT_VSTR + 16); v4u aw; aw.x = lo.x; aw.y = lo.y; aw.z = hi.x; aw.w = hi.y; O1 = MFMA32(__builtin_bit_cast(bf16x8, aw), pb, O1); }
                    }
                }
            }
            const float inv = 1.0f / l;
            bf16* op = AO + qrow * LDX + head * 64 + 4 * h;
#pragma unroll
            for (int i4 = 0; i4 < 4; ++i4) {
                v2u o; o.x = cvtpk(O0[4 * i4] * inv, O0[4 * i4 + 1] * inv); o.y = cvtpk(O0[4 * i4 + 2] * inv, O0[4 * i4 + 3] * inv); *(v2u*)(op + 8 * i4) = o;
                o.x = cvtpk(O1[4 * i4] * inv, O1[4 * i4 + 1] * inv); o.y = cvtpk(O1[4 * i4 + 2] * inv, O1[4 * i4 + 3] * inv); *(v2u*)(op + 32 + 8 * i4) = o;
            }
#pragma unroll
            for (int ks = 0; ks < 4; ++ks) qf[ks] = qn[ks];
        }
        __syncthreads();
    }
}
__device__ __forceinline__ float gelu_tanh(float x) {
    const float z = 0.7978845608028654f * (x + 0.044715f * x * x * x);
    return x * __builtin_amdgcn_rcpf(1.0f + __builtin_amdgcn_exp2f(-2.0f * 1.4426950408889634f * z));
}
constexpr int S5_KT_ELEMS = 33 * 256, S5_BE_ELEMS = 128 * 512, S5_CP_ELEMS = 512 * 128;
constexpr int S5_XE_STRIDE = 132;
constexpr int S5_LDS_XE = 0, S5_LDS_KT = 128 * S5_XE_STRIDE * 4;
static_assert(S5_LDS_KT + S5_KT_ELEMS * 2 <= RING_BYTES, "S5 LDS map");

__device__ __forceinline__ void s5_tables(Frame& F, const float* lam_re, const float* lam_im, const float* log_step, const float* b_re, const float* b_im,
                                          const float* c_re, const float* c_im, bf16* KT, bf16* BE, bf16* CP, float* AT, int g0, int gstep) {
    LAS float* apr = (LAS float*)(F.lds); LAS float* api = apr + 33 * 64; LAS float* Cr = api + 33 * 64; LAS float* Ci = Cr + 1024; LAS float* Br = Ci + 1024; LAS float* Bi = Br + 64 * 17;
    LAS float* ffr = Bi + 64 * 17; LAS float* ffi = ffr + 64;
    const int tid = F.tid;
    for (int g = g0; g < SG; g += gstep) {
        const float delta = expf(log_step[g]);
        for (int e = tid; e < 33 * 64; e += NWAVES * 64) { const int tau = e >> 6, p = e & 63; const float lr = lam_re[g * SP + p], li = lam_im[g * SP + p];
            double ang = (double)li * (double)delta * (double)tau; ang -= 6.283185307179586 * rint(ang * 0.15915494309189535);
            float sn, cs; sincosf((float)ang, &sn, &cs); const float mag = expf(lr * delta * (float)tau); apr[p * 33 + tau] = mag * cs; api[p * 33 + tau] = mag * sn; }
        for (int e = tid; e < 1024; e += NWAVES * 64) { const int c = e >> 6, p = e & 63; Cr[p * 16 + c] = c_re[(size_t)g * 1024 + e]; Ci[p * 16 + c] = c_im[(size_t)g * 1024 + e]; }
        if (tid < 64) { const int p = tid; const float lr = lam_re[g * SP + p], li = lam_im[g * SP + p];
            double ang = (double)li * (double)delta; ang -= 6.283185307179586 * rint(ang * 0.15915494309189535);
            const float y = (float)ang, x = lr * delta; float sn, cs, sh, ch; sincosf(y, &sn, &cs); sincosf(0.5f * y, &sh, &ch);
            const float em1 = expm1f(x); const float nr = em1 * cs - 2.0f * sh * sh, ni = (em1 + 1.0f) * sn, den = lr * lr + li * li;
            ffr[p] = (nr * lr + ni * li) / den; ffi[p] = (ni * lr - nr * li) / den; }
        __syncthreads();
        for (int e = tid; e < 1024; e += NWAVES * 64) { const int p = e >> 4; const float Bre = b_re[(size_t)g * 1024 + e], Bim = b_im[(size_t)g * 1024 + e], fr = ffr[p], fi = ffi[p];
            Br[p * 17 + (e & 15)] = fr * Bre - fi * Bim; Bi[p * 17 + (e & 15)] = fr * Bim + fi * Bre; }
        __syncthreads();
        {
            const int tau = tid >> 4, c = tid & 15; float acc[16];
#pragma unroll
            for (int cc = 0; cc < 16; ++cc) acc[cc] = 0.f;
            for (int p = 0; p < 64; ++p) { const float cr = Cr[p * 16 + c], ci = Ci[p * 16 + c], pr = apr[p * 33 + tau], pi = api[p * 33 + tau];
                const float er = cr * pr - ci * pi, ei = cr * pi + ci * pr;
#pragma unroll
                for (int cc = 0; cc < 16; ++cc) acc[cc] += er * Br[p * 17 + cc] - ei * Bi[p * 17 + cc]; }
            v4u o0, o1; o0.x = pk2(acc[0], acc[1]); o0.y = pk2(acc[2], acc[3]); o0.z = pk2(acc[4], acc[5]); o0.w = pk2(acc[6], acc[7]);
            o1.x = pk2(acc[8], acc[9]); o1.y = pk2(acc[10], acc[11]); o1.z = pk2(acc[12], acc[13]); o1.w = pk2(acc[14], acc[15]);
            v4u* dst = (v4u*)(KT + (size_t)g * S5_KT_ELEMS + (tau + 1) * 256 + c * 16); dst[0] = o0; dst[1] = o1;
            if (tid < 16) { v4u* z = (v4u*)(KT + (size_t)g * S5_KT_ELEMS + tid * 16); const v4u zz = {0u, 0u, 0u, 0u}; z[0] = zz; z[1] = zz; }
        }
        {
            const int pp = tid >> 2, sq = tid & 3, p = pp & 63; const bool im = pp >= 64;
            for (int s = 8 * sq; s < 8 * sq + 8; ++s) { const float pr = apr[p * 33 + (31 - s)], pi = api[p * 33 + (31 - s)]; float v[16];
#pragma unroll
                for (int cc = 0; cc < 16; ++cc) { const float br = Br[p * 17 + cc], bi = Bi[p * 17 + cc]; v[cc] = im ? (pr * bi + pi * br) : (pr * br - pi * bi); }
                v4u o0, o1; o0.x = pk2(v[0], v[1]); o0.y = pk2(v[2], v[3]); o0.z = pk2(v[4], v[5]); o0.w = pk2(v[6], v[7]);
                o1.x = pk2(v[8], v[9]); o1.y = pk2(v[10], v[11]); o1.z = pk2(v[12], v[13]); o1.w = pk2(v[14], v[15]);
                v4u* dst = (v4u*)(BE + (size_t)g * S5_BE_ELEMS + (size_t)pp * 512 + s * 16); dst[0] = o0; dst[1] = o1; }
        }
        {
            const int t = tid >> 4, c = tid & 15; bf16* dst = CP + (size_t)g * S5_CP_ELEMS + (size_t)tid * 128;
            for (int p0 = 0; p0 < 64; p0 += 8) { float er[8], ei[8];
#pragma unroll
                for (int j = 0; j < 8; ++j) { const int p = p0 + j; const float cr = Cr[p * 16 + c], ci = Ci[p * 16 + c], pr = apr[p * 33 + t + 1], pi = api[p * 33 + t + 1];
                    er[j] = cr * pr - ci * pi; ei[j] = -(cr * pi + ci * pr); }
                v4u o; o.x = pk2(er[0], er[1]); o.y = pk2(er[2], er[3]); o.z = pk2(er[4], er[5]); o.w = pk2(er[6], er[7]); *(v4u*)(dst + p0) = o;
                o.x = pk2(ei[0], ei[1]); o.y = pk2(ei[2], ei[3]); o.z = pk2(ei[4], ei[5]); o.w = pk2(ei[6], ei[7]); *(v4u*)(dst + 64 + p0) = o; }
        }
        if (tid < 64) { AT[(size_t)g * 128 + tid * 2] = apr[tid * 33 + 32]; AT[(size_t)g * 128 + tid * 2 + 1] = api[tid * 33 + 32]; }
        __syncthreads();
    }
}

__device__ __forceinline__ bf16x8 pack8(const f32x4 lo, const f32x4 hi) {
    v4u w; w.x = pg8::cvt_pk_bf16(lo[0], lo[1]); w.y = pg8::cvt_pk_bf16(lo[2], lo[3]); w.z = pg8::cvt_pk_bf16(hi[0], hi[1]); w.w = pg8::cvt_pk_bf16(hi[2], hi[3]);
    return __builtin_bit_cast(bf16x8, w);
}
constexpr int S5_US_STRIDE = 1056;
constexpr int S5_LDS_US = S5_LDS_KT + S5_KT_ELEMS * 2;
static_assert(S5_LDS_US % 16 == 0 && S5_LDS_US + 32 * S5_US_STRIDE <= RING_BYTES, "S5 LDS map");
__device__ __forceinline__ void s5_mixer(Frame& F, const ssq_t* ss, const float* gain, const bf16* HS, const bf16* KT, const bf16* BE, const bf16* CP, const float* AT, const float* d_skip, bf16* YG) {
    LAS float* XE = (LAS float*)(F.lds + S5_LDS_XE);
    LAS unsigned char* KTl = F.lds + S5_LDS_KT;
    LAS unsigned char* US = F.lds + S5_LDS_US;
    const int lane = F.lane, r = lane & 31, h = lane >> 5, w = F.wave;
    for (int u = F.vcu; u < 2 * SG; u += F.G) {
        const int g = u & (SG - 1), b = u >> 8;
        const bf16* Hs = HS + (size_t)u * SEQ * SGC;
        const v4u* slab4 = (const v4u*)Hs;
        int sdst[4];
#pragma unroll
        for (int i = 0; i < 4; ++i) { const int q = F.tid + 512 * i, tok = q >> 1; sdst[i] = (tok >> 5) * S5_US_STRIDE + (tok & 31) * 32 + (q & 1) * 16; }
        float gn[8];
#pragma unroll
        for (int c = 0; c < 8; ++c) gn[c] = gain[g * SGC + 8 * (F.tid & 1) + c];
        const ssq_t* ssb = ss + (size_t)b * SEQ;
#define S5_STAGE_LOAD(nb_) do { _Pragma("unroll") for (int i = 0; i < 4; ++i) { st[i] = slab4[(nb_) * 2048 + F.tid + 512 * i]; sv[i] = ss_get(ssb, (nb_) * 1024 + ((F.tid + 512 * i) >> 1)); } } while (0)
#define S5_STAGE_STORE() do { _Pragma("unroll") for (int i = 0; i < 4; ++i) { const float rs = __builtin_amdgcn_rsqf(sv[i] * (1.0f / DM) + EPS); v4u o; \
            o.x = pk2(xlo(st[i].x) * rs * gn[0], xhi(st[i].x) * rs * gn[1]); o.y = pk2(xlo(st[i].y) * rs * gn[2], xhi(st[i].y) * rs * gn[3]); \
            o.z = pk2(xlo(st[i].z) * rs * gn[4], xhi(st[i].z) * rs * gn[5]); o.w = pk2(xlo(st[i].w) * rs * gn[6], xhi(st[i].w) * rs * gn[7]); \
            *(LAS v4u*)(US + sdst[i]) = o; } } while (0)
        const LAS unsigned char* ufrag = US + r * S5_US_STRIDE + 16 * h;
        { const v4u* src = (const v4u*)(KT + (size_t)g * S5_KT_ELEMS); LAS v4u* dst = (LAS v4u*)KTl; for (int e = F.tid; e < S5_KT_ELEMS * 2 / 16; e += NWAVES * 64) dst[e] = src[e];
 }
        __syncthreads();
        {
            const int mb = w & 3, sh = w >> 2;
            bf16x8 ber[16];
            { const bf16* BEb = BE + (size_t)g * S5_BE_ELEMS + (size_t)(32 * mb + r) * 512 + (16 * sh) * 16 + 8 * h;
#pragma unroll
              for (int si = 0; si < 16; ++si) ber[si] = *(const bf16x8*)(BEb + si * 16); }
            v4u st[4]; float sv[4];
            S5_STAGE_LOAD(0);
#pragma unroll 1
            for (int nb = 0; nb < 4; ++nb) {
                S5_STAGE_STORE();
                __syncthreads();
                if (nb < 3) S5_STAGE_LOAD(nb + 1);
                f32x16 acc0, acc1;
#pragma unroll
                for (int i = 0; i < 16; ++i) { acc0[i] = 0.f; acc1[i] = 0.f; }
#pragma unroll
                for (int si = 0; si < 16; si += 2) { const bf16x8 u0 = *(const LAS bf16x8*)(ufrag + (16 * sh + si) * 32), u1 = *(const LAS bf16x8*)(ufrag + (16 * sh + si + 1) * 32);
                    acc0 = MFMA32(ber[si], u0, acc0); acc1 = MFMA32(ber[si + 1], u1, acc1); }
                LAS float* xrow = XE + (32 * nb + r) * S5_XE_STRIDE + 32 * mb + 4 * h;
                if (sh == 0) {
#pragma unroll
                    for (int i4 = 0; i4 < 4; ++i4) *(LAS f32x4*)(xrow + 8 * i4) = (f32x4){acc0[4 * i4] + acc1[4 * i4], acc0[4 * i4 + 1] + acc1[4 * i4 + 1], acc0[4 * i4 + 2] + acc1[4 * i4 + 2], acc0[4 * i4 + 3] + acc1[4 * i4 + 3]};
                }
                __syncthreads();
                if (sh == 1) {
#pragma unroll
                    for (int i4 = 0; i4 < 4; ++i4) { const f32x4 o = *(const LAS f32x4*)(xrow + 8 * i4);
                        *(LAS f32x4*)(xrow + 8 * i4) = (f32x4){o[0] + acc0[4 * i4] + acc1[4 * i4], o[1] + acc0[4 * i4 + 1] + acc1[4 * i4 + 1], o[2] + acc0[4 * i4 + 2] + acc1[4 * i4 + 2], o[3] + acc0[4 * i4 + 3] + acc1[4 * i4 + 3]}; }
                }
            }
            __syncthreads();
        }
        if (w == 0) {
            const float atr = AT[(size_t)g * 128 + lane * 2], ati = AT[(size_t)g * 128 + lane * 2 + 1];
            float xr = 0.f, xi = 0.f;
            for (int k0 = 0; k0 < 127; k0 += 8) {
                float er[8], ei[8];
#pragma unroll
                for (int i = 0; i < 8; ++i) if (k0 + i < 127) { er[i] = XE[(k0 + i) * S5_XE_STRIDE + lane]; ei[i] = XE[(k0 + i) * S5_XE_STRIDE + 64 + lane]; }
#pragma unroll
                for (int i = 0; i < 8; ++i) if (k0 + i < 127) { const float nxr = atr * xr - ati * xi + er[i], nxi = atr * xi + ati * xr + ei[i]; xr = nxr; xi = nxi; er[i] = xr; ei[i] = xi; }
#pragma unroll
                for (int i = 0; i < 8; ++i) if (k0 + i < 127) { XE[(k0 + i) * S5_XE_STRIDE + lane] = er[i]; XE[(k0 + i) * S5_XE_STRIDE + 64 + lane] = ei[i]; }
            }
        }
        {
            const int jA = w, jB = 15 - w;
            bf16x8 cpa[8], cpb[8];
            { const bf16* CPg = CP + (size_t)g * S5_CP_ELEMS + (size_t)r * 128 + 8 * h;
#pragma unroll
              for (int ks = 0; ks < 8; ++ks) { cpa[ks] = *(const bf16x8*)(CPg + (size_t)(32 * jA) * 128 + 16 * ks); cpb[ks] = *(const bf16x8*)(CPg + (size_t)(32 * jB) * 128 + 16 * ks); } }
            const f32x4 dsk0 = *(const f32x4*)(d_skip + g * SGC + 4 * h), dsk1 = *(const f32x4*)(d_skip + g * SGC + 8 + 4 * h);
            const int ktl = ((r >> 4) * 256 + (r & 15) * 16 + 8 * h) * 2;
            v4u st[4]; float sv[4];
            S5_STAGE_LOAD(0);
            __syncthreads();
            {
#pragma unroll 1
            for (int nb = 0; nb < 4; ++nb) {
                S5_STAGE_STORE();
                __syncthreads();
                if (nb < 3) S5_STAGE_LOAD(nb + 1);
                const int kc = 32 * nb + r;
                f32x16 cA, cB;
#pragma unroll
                for (int i = 0; i < 16; ++i) { cA[i] = 0.f; cB[i] = 0.f; }
#pragma unroll
                for (int ks = 0; ks < 8; ++ks) {
                    f32x4 lo = {0.f, 0.f, 0.f, 0.f}, hi = {0.f, 0.f, 0.f, 0.f};
                    if (kc >= 1) { const LAS float* xp = XE + (kc - 1) * S5_XE_STRIDE + 16 * ks + 8 * h; lo = *(const LAS f32x4*)xp; hi = *(const LAS f32x4*)(xp + 4); }
                    const bf16x8 xb = pack8(lo, hi);
                    cA = MFMA32(cpa[ks], xb, cA); cB = MFMA32(cpb[ks], xb, cB);
                }
                const int nA = 2 * jA + 2, nB = 2 * jB + 2;
                const LAS unsigned char* ka = KTl + ktl + (2 * jA + 1) * 512; const LAS unsigned char* kb = KTl + ktl + (2 * jB + 1) * 512;
                {
#define S5_U(s_) (*(const LAS bf16x8*)(ufrag + (s_) * 32))
#define S5_KA(s_) (*(const LAS bf16x8*)(ka - (s_) * 512))
#define S5_KB(s_) (*(const LAS bf16x8*)(kb - (s_) * 512))
                    bf16x8 u0 = S5_U(0), u1 = S5_U(1), a0 = S5_KA(0), a1 = S5_KA(1), b0 = S5_KB(0), b1 = S5_KB(1);
#pragma unroll 1
                    for (int s = 0; s < nA; s += 2) {
                        const bf16x8 nu0 = S5_U(s + 2), nu1 = S5_U(s + 3), na0 = S5_KA(s + 2), na1 = S5_KA(s + 3), nb0 = S5_KB(s + 2), nb1 = S5_KB(s + 3);
                        cA = MFMA32(a0, u0, cA); cB = MFMA32(b0, u0, cB); cA = MFMA32(a1, u1, cA); cB = MFMA32(b1, u1, cB);
                        u0 = nu0; u1 = nu1; a0 = na0; a1 = na1; b0 = nb0; b1 = nb1;
                    }
#pragma unroll 1
                    for (int s = nA; s < nB; s += 2) {
                        const bf16x8 nu0 = S5_U(s + 2), nu1 = S5_U(s + 3), nb0 = S5_KB(s + 2), nb1 = S5_KB(s + 3);
                        cB = MFMA32(b0, u0, cB); cB = MFMA32(b1, u1, cB);
                        u0 = nu0; u1 = nu1; b0 = nb0; b1 = nb1;
                    }
#undef S5_U
#undef S5_KA
#undef S5_KB
                }
#define S5_EPI(cacc, jj) do { _Pragma("unroll") for (int i4 = 0; i4 < 4; ++i4) { \
                    const int t = 2 * (jj) + (i4 >> 1), c0i = 8 * (i4 & 1) + 4 * h; const size_t off = ((size_t)(b * SEQ + kc * 32 + t)) * LDX + g * SGC + c0i; \
                    const v2u uw = *(const LAS v2u*)(US + r * S5_US_STRIDE + t * 32 + c0i * 2); const f32x4 dk = (i4 & 1) ? dsk1 : dsk0; \
                    const float y0 = cacc[4 * i4] + dk[0] * bf_lo(uw.x), y1 = cacc[4 * i4 + 1] + dk[1] * bf_hi(uw.x), y2 = cacc[4 * i4 + 2] + dk[2] * bf_lo(uw.y), y3 = cacc[4 * i4 + 3] + dk[3] * bf_hi(uw.y); \
                    v2u ow; ow.x = pg8::cvt_pk_bf16(gelu_tanh(y0), gelu_tanh(y1)); ow.y = pg8::cvt_pk_bf16(gelu_tanh(y2), gelu_tanh(y3)); *(v2u*)(YG + off) = ow; } } while (0)
                S5_EPI(cA, jA); S5_EPI(cB, jB);
#undef S5_EPI
                __syncthreads();
            }
            }
        }
#undef S5_STAGE_LOAD
#undef S5_STAGE_STORE
    }
}
__device__ __forceinline__ void conv_fixup(Frame& F, const float* HEAD, const float* TAIL, const float* cw, const float* cb, bf16* ACT, const float* wsc) {
    const int gt = F.vcu * NWAVES * 64 + F.tid, NGT = F.G * NWAVES * 64;
    for (int it = gt; it < (M / 256) * FF; it += NGT) {
        const int blk = it / FF, f = it - blk * FF;
        const int nn = ((f >> 7) << 8) + (f & 127);
        float c0[2], c1[2];
#pragma unroll
        for (int bj = 0; bj < 2; ++bj) {
            const int col = bj * FF + f, nc = nn + bj * 128;
            const float sc = wsc ? wsc[nc] : 1.0f; const float w0 = cw[col] * sc, w1 = cw[NUP + col] * sc, w2 = cw[2 * NUP + col] * sc, bb = cb[col];
            float t0 = 0.f, t1 = 0.f;
            if ((blk & 15) != 0) {
            t0 = TAIL[((size_t)(blk - 1) * 2 + 0) * NUP + nc]; t1 = TAIL[((size_t)(blk - 1) * 2 + 1) * NUP + nc]; }
            const float h0 = HEAD[((size_t)blk * 2 + 0) * NUP + nc], h1 = HEAD[((size_t)blk * 2 + 1) * NUP + nc];
            c0[bj] = bb + w0 * t0 + w1 * t1 + w2 * h0;
            c1[bj] = bb + w0 * t1 + w1 * h0 + w2 * h1;
        }
        const float o0 = c0[0] * pg8::fast_sigmoid(c0[0]) * c0[1], o1 = c1[0] * pg8::fast_sigmoid(c1[0]) * c1[1];
        ACT[(size_t)(blk * 256) * LDACT + f] = (bf16)f2bf(o0);
        ACT[(size_t)(blk * 256 + 1) * LDACT + f] = (bf16)f2bf(o1);
    }
}

struct Args { const float* in[22]; float* out; unsigned char* ws; int ph_lo, ph_hi, li, pad; };
__global__ void __launch_bounds__(NWAVES * 64, 2) mk_fwd(Args args) {
    extern __shared__ __attribute__((aligned(16))) unsigned char lds[];
    Frame F;
    F.lds = (LAS unsigned char*)lds;
    F.MISC = (volatile LAS unsigned*)(F.lds + MISC_OFF);
    F.tid = threadIdx.x; F.lane = F.tid & 63; F.wave = __builtin_amdgcn_readfirstlane(F.tid >> 6);
    F.G = gridDim.x; { const int bx = blockIdx.x; F.vcu = (F.G % 8 == 0) ? (bx % 8) * (F.G / 8) + bx / 8 : bx; }
    unsigned char* ws = args.ws;
    F.ctl = (gu32*)(ws + WS_CTL);
    for (int u = F.tid; u < (LDS_BYTES - LDSCTL_OFF) / 4; u += NWAVES * 64) ((LAS unsigned*)(F.lds + LDSCTL_OFF))[u] = 0u;
    __syncthreads();
    XcdBarrier bar; bar.bar = (unsigned*)(F.ctl + CW_BAR); bar.x = 0; bar.st = nullptr;
    if (N_LAUNCHES == 1) bar = xcd_barrier_post((unsigned*)(F.ctl + CW_BAR), F.MISC + 8);
#define GRID_BAR() do { if (N_LAUNCHES == 1) xcd_barrier(bar); } while (0)
    const int lo = args.ph_lo, hi = args.ph_hi;
#define IN(k) (lo <= (k) && (k) < hi)
#define BOTH(k) (IN(k) && IN((k) + 1))
    const float* x_in = args.in[0];
    float* X = (float*)(ws + WS_X);
    bf16* XNB = (bf16*)(ws + WS_XNB);
    bf16* XN = (bf16*)(ws + WS_XN); bf16* QKV = (bf16*)(ws + WS_QKV); bf16* AO = (bf16*)(ws + WS_AO); bf16* ACT = (bf16*)(ws + WS_ACT);
    float* HEAD = (float*)(ws + WS_HEAD); float* TAIL = (float*)(ws + WS_TAIL);

    ssq_t* SS0 = (ssq_t*)(ws + WS_SS); ssq_t* SS1 = SS0 + M; ssq_t* SS2 = SS1 + M; ssq_t* SS3 = SS2 + M; ssq_t* SS4 = SS3 + M;
    const float INVD = 1.0f / DM;
    LAS float* TLX = (LAS float*)(F.lds + LDSCTL_OFF + 1024);
#ifndef CVT_P0
#define CVT_P0 10240
#endif
    static_assert(CVT_P0 >= CI_QKV && CVT_P0 <= CVT_ITEMS, "prologue share");
    const bool split = (F.G == 256);
    const bool defer = false;
    if (IN(0)) { if (!split) s5_tables(F, args.in[7], args.in[8], args.in[9], args.in[10], args.in[11], args.in[12], args.in[13], (bf16*)(ws + WS_S5KT), (bf16*)(ws + WS_S5BE), (bf16*)(ws + WS_S5CP), (float*)(ws + WS_S5AT), (int)blockIdx.x, F.G);
        convert_weights(F, args.in, ws, 0, split ? CVT_P0 : (defer ? CVT_NP : CVT_ITEMS), F.vcu * NWAVES + F.wave, F.G * NWAVES); if (!split) convert_panels(F, args.in, ws, 0, NPAN, (int)blockIdx.x, F.G); x0_rows(F, x_in, XN, XNB, SS0); if (BOTH(0)) GRID_BAR(); }
    if (IN(1)) { pg8::Gemm g{XNB, (const bf16*)(ws + WS_WQKV), M, QKVW, DM, LDX, LDW}; pg8::StaticOrder S;
#ifndef QKV_WGS
#define QKV_WGS 128
#endif
        const bool gemm_side = !split || (int)blockIdx.x < QKV_WGS;
        if (split) S.init(M, QKVW, QKV_WGS, (int)blockIdx.x); else S.init(M, QKVW, F.G, (int)blockIdx.x);
        pg8::EpiBf16Scale E{QKV, QKVW, pg8::RowScale{SS0, nullptr, INVD, EPS}};
#ifndef CVT_GSIDE
#define CVT_GSIDE 12288
#endif
#ifndef CVT_T4
#define CVT_T4 14336
#define CVT_T9 7168
#endif
        constexpr int CVT_TAIL = CVT_T4 + CVT_T9;
        static_assert(CVT_TAIL <= CI_DN && CVT_TAIL + CVT_GSIDE + CVT_P0 <= CVT_ITEMS, "deferred conversion items");
        const int cvt_tail = split ? CVT_TAIL : 0;
        if (gemm_side) { pg8::gemm_phase<pg8::EpiBf16Scale, pg8::StaticOrder, true, true>(F.lds + RING_OFF, g, S, E);
            if (split) convert_weights(F, args.in, ws, CVT_ITEMS - CVT_TAIL - CVT_GSIDE, CVT_GSIDE, (int)blockIdx.x * NWAVES + F.wave, QKV_WGS * NWAVES); }
        else { s5_tables(F, args.in[7], args.in[8], args.in[9], args.in[10], args.in[11], args.in[12], args.in[13], (bf16*)(ws + WS_S5KT), (bf16*)(ws + WS_S5BE), (bf16*)(ws + WS_S5CP), (float*)(ws + WS_S5AT), (int)blockIdx.x - QKV_WGS, 256 - QKV_WGS);
            convert_weights(F, args.in, ws, CVT_P0, CVT_ITEMS - CVT_P0 - CVT_GSIDE - cvt_tail, ((int)blockIdx.x - QKV_WGS) * NWAVES + F.wave, (256 - QKV_WGS) * NWAVES);
            convert_panels(F, args.in, ws, 0, NPAN, (int)blockIdx.x - QKV_WGS, 256 - QKV_WGS); }
        if (defer && blockIdx.x >= 128) convert_weights(F, args.in, ws, CVT_NP, CVT_N1, ((int)blockIdx.x - 128) * NWAVES + F.wave, CVT_W1);
        if (BOTH(1)) GRID_BAR(); }
    if (IN(2)) { attn_mfma(F, QKV, args.in[4], args.in[5], AO);
        for (int i = NI8 + (int)blockIdx.x * 512 + F.tid; i < NUP; i += F.G * 512) ((float*)(ws + WS_WSC0))[i] = 1.0f;
        if (BOTH(2)) GRID_BAR(); }
    if (IN(3)) { pg8::Gemm g{AO, (const bf16*)(ws + WS_WO), M, DM, DM, LDX, LDW}; pg8::StaticOrder S; S.init(M, DM, F.G, (int)blockIdx.x);
        pg8::EpiRes<false, false> E{XN, LDX, XN, LDX, SS1, nullptr, XNB};
        pg8::gemm_phase<pg8::EpiRes<false, false>, pg8::StaticOrder, true, true>(F.lds + RING_OFF, g, S, E);
        if (BOTH(3)) GRID_BAR(); }
    if (IN(4)) { quant_rows<true>(F, XN, 0, M, LDX, ws + WS_XQ, (float*)(ws + WS_ASC), SS1, F.vcu * NWAVES + F.wave, F.G * NWAVES); GRID_BAR();
        { pg8::Gemm g{(const bf16*)(ws + WS_XQ), (const bf16*)(ws + WS_WQ0), M, NI8, DM / 2, LDQ / 2, LDQ / 2}; pg8::StaticOrder S; S.init(M, NI8, F.G, (int)blockIdx.x);
          pg8::EpiConvGate E{ACT, LDACT, HEAD, TAIL, args.in[18], args.in[19], FF, NUP, pg8::RowScale{nullptr, (const float*)(ws + WS_ASC), 0.f, 0.f}, TLX, (const float*)(ws + WS_WSC0)};
          pg8::gemm_phase_i8<pg8::EpiConvGate, pg8::StaticOrder, true, true>(F.lds + RING_OFF, g, S, E); }
        __syncthreads();
        int tz; asm volatile("s_mov_b32 %0, 0" : "=s"(tz));
        { pg8::Gemm g{XNB, (const bf16*)(ws + WS_WUP0) + (size_t)NI8 * LDW, M, NUP - NI8, DM, LDX, LDW}; pg8::StaticOrder S; S.init(M, NUP - NI8, F.G, (int)blockIdx.x);
          pg8::EpiConvGate E{ACT + NI8 / 2, LDACT, HEAD + NI8, TAIL + NI8, args.in[18] + NI8 / 2, args.in[19] + NI8 / 2, FF, NUP, pg8::RowScale{SS1, nullptr, INVD, EPS}, TLX, nullptr};
          pg8::gemm_phase<pg8::EpiConvGate, pg8::StaticOrder, true, true>(F.lds + RING_OFF, g, S, E, tz); }
        if (split && blockIdx.x >= 192) { __syncthreads(); convert_weights(F, args.in, ws, CVT_ITEMS - CVT_T4 - CVT_T9, CVT_T4, ((int)blockIdx.x - 192) * NWAVES + F.wave, 64 * NWAVES); }
        if (BOTH(4)) GRID_BAR(); }
    if (IN(5)) { conv_fixup(F, HEAD, TAIL, args.in[18], args.in[19], ACT, (const float*)(ws + WS_WSC0));
        if (BOTH(5)) GRID_BAR(); }
    if (IN(6)) { pg8::Gemm g{ACT, (const bf16*)(ws + WS_WDN0), M, DM, FF, LDACT, LDWF}; pg8::StaticOrder S; S.init(M, DM, F.G, (int)blockIdx.x);
        pg8::EpiRes<false, false> E{XN, LDX, XN, LDX, SS2, (bf16*)(ws + WS_S5H), nullptr};
        pg8::gemm_phase<pg8::EpiRes<false, false>, pg8::StaticOrder, true, true>(F.lds + RING_OFF, g, S, E);
        if (BOTH(6)) GRID_BAR(); }
    if (IN(7)) { s5_mixer(F, SS2, args.in[6], (const bf16*)(ws + WS_S5H), (const bf16*)(ws + WS_S5KT), (const bf16*)(ws + WS_S5BE), (const bf16*)(ws + WS_S5CP), (const float*)(ws + WS_S5AT), args.in[14], AO);
        if (BOTH(7)) GRID_BAR(); }
    if (IN(8)) { pg8::Gemm g{AO, (const bf16*)(ws + WS_WGLU), M, 2 * DM, DM, LDX, LDW}; pg8::StaticOrder S; S.init(M, 2 * DM, F.G, (int)blockIdx.x);
        pg8::EpiGluRes E{XN, LDX, SS3};
        pg8::gemm_phase<pg8::EpiGluRes, pg8::StaticOrder, true, true>(F.lds + RING_OFF, g, S, E);
        if (BOTH(8)) GRID_BAR(); }
    if (IN(9)) { quant_rows<true>(F, XN, 0, M, LDX, ws + WS_XQ, (float*)(ws + WS_ASC), SS3, F.vcu * NWAVES + F.wave, F.G * NWAVES); GRID_BAR();
        pg8::Gemm g{(const bf16*)(ws + WS_XQ), (const bf16*)(ws + WS_WQ1), M, NUP, DM / 2, LDQ / 2, LDQ / 2}; pg8::StaticOrder S; S.init(M, NUP, F.G, (int)blockIdx.x);
        pg8::EpiConvGate E{ACT, LDACT, HEAD, TAIL, args.in[18] + 3 * NUP, args.in[19] + NUP, FF, NUP, pg8::RowScale{nullptr, (const float*)(ws + WS_ASC), 0.f, 0.f}, TLX, (const float*)(ws + WS_WSC1)};
        pg8::gemm_phase_i8<pg8::EpiConvGate, pg8::StaticOrder, true, true>(F.lds + RING_OFF, g, S, E);
        if (split && blockIdx.x >= 192) { __syncthreads(); convert_weights(F, args.in, ws, CVT_ITEMS - CVT_T9, CVT_T9, ((int)blockIdx.x - 192) * NWAVES + F.wave, 64 * NWAVES); }
        if (BOTH(9)) GRID_BAR(); }
    if (IN(10)) { conv_fixup(F, HEAD, TAIL, args.in[18] + 3 * NUP, args.in[19] + NUP, ACT, (const float*)(ws + WS_WSC1)); if (BOTH(10)) GRID_BAR(); }
    if (IN(11)) { pg8::Gemm g{ACT, (const bf16*)(ws + WS_WDN1), M, DM, FF, LDACT, LDWF}; pg8::StaticOrder S; S.init(M, DM, F.G, (int)blockIdx.x);
        pg8::EpiRes<false, false> E{XN, LDX, XN, LDX, SS4, nullptr, nullptr};
        pg8::gemm_phase<pg8::EpiRes<false, false>, pg8::StaticOrder, true, true>(F.lds + RING_OFF, g, S, E);
        if (BOTH(11)) GRID_BAR(); }
    if (IN(12)) { final_rows(F, XN, SS4, args.in[21], args.out); }
#undef IN
#undef BOTH
}

extern "C" void kernel_launch(void* const* d_in, const int* in_sizes, int n_in, void* d_out, int out_size, void* d_ws, size_t ws_size, hipStream_t stream) {
    static int grid = 0;
    if (grid == 0) {
        if (n_in != 22 || out_size != M * DM || ws_size < WS_END) { fprintf(stderr, "kernel_launch: unexpected shapes (n_in %d, out %d, ws %zu < %zu)\n", n_in, out_size, ws_size, (size_t)WS_END); grid = -1; return; }
        int dev = 0, cus = 0, per_cu = 0;
        if (hipGetDevice(&dev) != hipSuccess || hipDeviceGetAttribute(&cus, hipDeviceAttributeMultiprocessorCount, dev) != hipSuccess) { grid = -1; return; }
        if (hipFuncSetAttribute((const void*)mk_fwd, hipFuncAttributeMaxDynamicSharedMemorySize, LDS_BYTES) != hipSuccess) { fprintf(stderr, "kernel_launch: hipFuncSetAttribute failed\n"); grid = -1; return; }
        if (hipOccupancyMaxActiveBlocksPerMultiprocessor(&per_cu, (const void*)mk_fwd, NWAVES * 64, LDS_BYTES) != hipSuccess || per_cu < 1) { fprintf(stderr, "kernel_launch: occupancy query reports %d\n", per_cu); }
        (void)hipGetLastError();
        grid = cus;
    }
    if (grid < 0) return;
    if (hipMemsetAsync((char*)d_ws + WS_CTL, 0, CTL_ZERO_BYTES, stream) != hipSuccess) return;
    Args a{};
    for (int i = 0; i < 22; ++i) a.in[i] = (const float*)d_in[i];
    a.out = (float*)d_out; a.ws = (unsigned char*)d_ws;
    for (int li = 0; li < N_LAUNCHES; ++li) {
        if (N_LAUNCHES == 1) { a.ph_lo = 0; a.ph_hi = N_PHASES; } else { a.ph_lo = li; a.ph_hi = li + 1; }
        a.li = li; a.pad = 0;
        hipLaunchKernelGGL(mk_fwd, dim3(grid), dim3(NWAVES * 64), LDS_BYTES, stream, a);
    }
}
```
